# Optimizing an MI355X kernel written in HIP

```python
import math
import jax
import jax.numpy as jnp
from jax import lax
import numpy as np

D_MODEL = 1024
BATCH = 2
SEQ = 8192
DEPTH = 1

ATTN_HEADS = 8
ATTN_HEAD_DIM = 64
ATTN_WIDTH = ATTN_HEADS * ATTN_HEAD_DIM
HGRN_HEADS = 8
HGRN_HEAD_DIM = 64
HGRN_WIDTH = HGRN_HEADS * HGRN_HEAD_DIM
MIX_WIDTH = ATTN_WIDTH + HGRN_WIDTH
IN_SIZES = (ATTN_WIDTH, ATTN_WIDTH, ATTN_WIDTH, HGRN_WIDTH, HGRN_WIDTH, HGRN_WIDTH, HGRN_WIDTH)
IN_WIDTH = sum(IN_SIZES)
MOBA_BLOCK = 256
MOBA_TOPK = 3
Q_BLOCK = 64
HGRN_CHUNK = 64
N_BUCKETS = 32
MAX_DISTANCE = 128
N_GROUPS = 4
EXPERTS_PER_GROUP = 4
N_EXPERTS = N_GROUPS * EXPERTS_PER_GROUP
EXPERT_TOPK = 2
D_EXPERT = 512
LN_EPS = 1e-5
RMS_EPS = 1e-6
DEEPNORM_ALPHA = (2.0 * DEPTH) ** 0.25
DEEPNORM_BETA = (8.0 * DEPTH) ** -0.25

kernel_name = 'hybrid_moba_hgrn2_hiermoe_deepnorm'


def layer_norm(x, g, b):
    xf = x.astype(jnp.float32)
    mu = jnp.mean(xf, axis=-1, keepdims=True)
    var = jnp.mean(jnp.square(xf - mu), axis=-1, keepdims=True)
    y = (xf - mu) * lax.rsqrt(var + LN_EPS) * g.astype(jnp.float32) + b.astype(jnp.float32)
    return y.astype(x.dtype)


def t5_bucket(n):
    n = jnp.maximum(n, 0)
    max_exact = N_BUCKETS // 2
    nf = jnp.maximum(n, 1).astype(jnp.float32)
    large = max_exact + (jnp.log(nf / max_exact) / math.log(MAX_DISTANCE / max_exact)
                         * (N_BUCKETS - max_exact)).astype(jnp.int32)
    large = jnp.minimum(large, N_BUCKETS - 1)
    return jnp.where(n < max_exact, n, large)


def moba_attention(q, k, v, bias_table):
    B_, H, S, dh = q.shape
    n_blocks = -(-S // MOBA_BLOCK)
    pad = n_blocks * MOBA_BLOCK - S
    k_pad = jnp.pad(k, ((0, 0), (0, 0), (0, pad), (0, 0)))
    v_pad = jnp.pad(v, ((0, 0), (0, 0), (0, pad), (0, 0)))
    k_blocks = k_pad.reshape(B_, H, n_blocks, MOBA_BLOCK, dh)
    v_blocks = v_pad.reshape(B_, H, n_blocks, MOBA_BLOCK, dh)
    k_mean = jnp.mean(k_blocks.astype(jnp.float32), axis=3)
    n_sel = min(MOBA_TOPK, n_blocks)
    scale = dh ** -0.5
    bias_hb = bias_table.T.astype(jnp.float32)
    bi = jnp.arange(B_)[:, None, None, None]
    hi = jnp.arange(H)[None, :, None, None]
    blk_ids = jnp.arange(n_blocks)
    offs = jnp.arange(MOBA_BLOCK)

    def per_query_block(qb):
        start = qb * Q_BLOCK
        q_c = lax.dynamic_slice_in_dim(q, start, Q_BLOCK, axis=2).astype(jnp.float32)
        q_pos = start + jnp.arange(Q_BLOCK)
        own = start // MOBA_BLOCK
        gate = jnp.einsum('bhqd,bhnd->bhqn', q_c, k_mean)
        gate = jnp.where(blk_ids < own, gate, -jnp.inf)
        _, sel = lax.top_k(gate, n_sel)
        k_sel = k_blocks[bi, hi, sel].astype(jnp.float32)
        v_sel = v_blocks[bi, hi, sel].astype(jnp.float32)
        kpos_sel = sel[..., None] * MOBA_BLOCK + offs
        l_sel = (jnp.einsum('bhqd,bhqjkd->bhqjk', q_c, k_sel) * scale
                 + bias_hb[hi[..., None], t5_bucket(q_pos[:, None, None] - kpos_sel)])
        l_sel = jnp.where((sel < own)[..., None], l_sel, -jnp.inf)
        l_sel = l_sel.reshape(B_, H, Q_BLOCK, n_sel * MOBA_BLOCK)
        k_own = lax.dynamic_slice_in_dim(k_pad, own * MOBA_BLOCK, MOBA_BLOCK, axis=2).astype(jnp.float32)
        v_own = lax.dynamic_slice_in_dim(v_pad, own * MOBA_BLOCK, MOBA_BLOCK, axis=2).astype(jnp.float32)
        rel = q_pos[:, None] - (own * MOBA_BLOCK + offs)[None, :]
        l_own = jnp.einsum('bhqd,bhkd->bhqk', q_c, k_own) * scale + bias_hb[:, t5_bucket(rel)][None]
        l_own = jnp.where(rel >= 0, l_own, -jnp.inf)
        p = jax.nn.softmax(jnp.concatenate([l_sel, l_own], axis=-1), axis=-1)
        p_sel = p[..., :n_sel * MOBA_BLOCK].reshape(B_, H, Q_BLOCK, n_sel, MOBA_BLOCK)
        p_own = p[..., n_sel * MOBA_BLOCK:]
        return (jnp.einsum('bhqjk,bhqjkd->bhqd', p_sel, v_sel)
                + jnp.einsum('bhqk,bhkd->bhqd', p_own, v_own))

    out = lax.map(per_query_block, jnp.arange(S // Q_BLOCK))
    out = out.transpose(1, 2, 0, 3, 4).reshape(B_, H, S, dh)
    return out.astype(q.dtype)


def hgrn2(q, f_logit, i, lb):
    B_, S, H, dk = q.shape
    C = HGRN_CHUNK
    nc = S // C
    f = lb + (1.0 - lb) * jax.nn.sigmoid(f_logit.astype(jnp.float32))
    log_f = jnp.log(f)
    kk = 1.0 - f
    qq = jax.nn.silu(q.astype(jnp.float32))
    vv = i.astype(jnp.float32)

    def chunks(t):
        return t.reshape(B_, nc, C, H, dk).transpose(1, 0, 3, 2, 4)

    causal = jnp.tril(jnp.ones((C, C), dtype=bool))

    def step(state, inp):
        qc, kc, vc, gc = inp
        b = jnp.cumsum(gc, axis=2)
        o_inter = jnp.einsum('bhck,bhkv->bhcv', qc * jnp.exp(b), state)
        diff = b[:, :, :, None, :] - b[:, :, None, :, :]
        decay = jnp.exp(jnp.where(causal[:, :, None], diff, -jnp.inf))
        A = jnp.einsum('bhtk,bhtsk,bhsk->bhts', qc, decay, kc)
        o_intra = jnp.einsum('bhts,bhsv->bhtv', A, vc)
        b_last = b[:, :, -1:, :]
        new_state = (jnp.exp(b_last[:, :, 0, :])[..., None] * state
                     + jnp.einsum('bhsk,bhsv->bhkv', kc * jnp.exp(b_last - b), vc))
        return new_state, o_inter + o_intra

    state0 = jnp.zeros((B_, H, dk, dk), jnp.float32)
    _, o = lax.scan(step, state0, (chunks(qq), chunks(kk), chunks(vv), chunks(log_f)))
    return o.transpose(1, 0, 3, 2, 4).reshape(B_, S, H, dk)


def hier_moe(x, w_group, b_group, w_expert, b_expert, w_gate, w_up, w_down):
    B_, S, D = x.shape
    xt = x.reshape(B_ * S, D)
    g_prob = jax.nn.softmax((xt @ w_group + b_group).astype(jnp.float32), axis=-1)
    g_w, g_idx = lax.top_k(g_prob, 1)
    g_w, g_idx = g_w[:, 0], g_idx[:, 0]
    e_logits_all = jnp.einsum('td,gde->tge', xt, w_expert) + b_expert
    e_logits = jnp.take_along_axis(e_logits_all, g_idx[:, None, None], axis=1)[:, 0]
    e_prob = jax.nn.softmax(e_logits.astype(jnp.float32), axis=-1)
    e_w, e_idx = lax.top_k(e_prob, EXPERT_TOPK)
    e_w = e_w / jnp.sum(e_w, axis=-1, keepdims=True)
    gid = g_idx[:, None] * EXPERTS_PER_GROUP + e_idx
    w_tok = g_w[:, None] * e_w
    combine = jnp.einsum('tk,tke->te', w_tok, jax.nn.one_hot(gid, N_EXPERTS, dtype=jnp.float32)).astype(x.dtype)
    y = jnp.zeros_like(xt)
    for e in range(N_EXPERTS):
        h = jax.nn.silu(xt @ w_gate[e]) * (xt @ w_up[e])
        y = y + combine[:, e:e + 1] * (h @ w_down[e])
    return y.reshape(B_, S, D)


def setup_inputs(seed: int = 0) -> dict:
    key = jax.random.key(seed)
    ks = jax.random.split(key, 20)
    f32 = jnp.float32
    nrm = lambda k, shape: jax.random.normal(k, shape, f32)
    beta = DEEPNORM_BETA
    col_scale = jnp.concatenate([jnp.full((s,), sc, f32) for s, sc in
                                 zip(IN_SIZES, (1.0, 1.0, beta, 1.0, 1.0, beta, 1.0))])
    return {
        'x': nrm(ks[0], (BATCH, SEQ, D_MODEL)),
        'w_in': nrm(ks[1], (DEPTH, D_MODEL, IN_WIDTH)) * D_MODEL ** -0.5 * col_scale,
        't5_bias': nrm(ks[2], (N_BUCKETS, ATTN_HEADS)) * 0.5,
        'hgrn_lb_logits': nrm(ks[3], (DEPTH + 1, HGRN_WIDTH)) * 0.5,
        'hgrn_norm_w': 1.0 + 0.01 * nrm(ks[4], (DEPTH, HGRN_WIDTH)),
        'w_o': nrm(ks[5], (DEPTH, MIX_WIDTH, D_MODEL)) * MIX_WIDTH ** -0.5 * beta,
        'ln1_g': 1.0 + 0.01 * nrm(ks[6], (DEPTH, D_MODEL)),
        'ln1_b': 0.01 * nrm(ks[7], (DEPTH, D_MODEL)),
        'w_group': nrm(ks[8], (DEPTH, D_MODEL, N_GROUPS)) * D_MODEL ** -0.5,
        'b_group': 0.01 * nrm(ks[9], (DEPTH, N_GROUPS)),
        'w_expert': nrm(ks[10], (DEPTH, N_GROUPS, D_MODEL, EXPERTS_PER_GROUP)) * D_MODEL ** -0.5,
        'b_expert': 0.01 * nrm(ks[11], (DEPTH, N_GROUPS, EXPERTS_PER_GROUP)),
        'w_gate': nrm(ks[12], (DEPTH, N_EXPERTS, D_MODEL, D_EXPERT)) * D_MODEL ** -0.5,
        'w_up': nrm(ks[13], (DEPTH, N_EXPERTS, D_MODEL, D_EXPERT)) * D_MODEL ** -0.5,
        'w_down': nrm(ks[14], (DEPTH, N_EXPERTS, D_EXPERT, D_MODEL)) * D_EXPERT ** -0.5 * beta,
        'ln2_g': 1.0 + 0.01 * nrm(ks[15], (DEPTH, D_MODEL)),
        'ln2_b': 0.01 * nrm(ks[16], (DEPTH, D_MODEL)),
    }


def reference(x, w_in, t5_bias, hgrn_lb_logits, hgrn_norm_w, w_o, ln1_g, ln1_b,
              w_group, b_group, w_expert, b_expert, w_gate, w_up, w_down, ln2_g, ln2_b):
    B_, S, D = x.shape
    lb_all = jnp.cumsum(jax.nn.softmax(hgrn_lb_logits.astype(jnp.float32), axis=0), axis=0)
    offsets = np.cumsum((0,) + IN_SIZES)
    for l in range(DEPTH):
        proj = jnp.einsum('bsd,de->bse', x, w_in[l])
        aq, ak, av, hq, hf, hi_, hg = [proj[..., offsets[j]:offsets[j + 1]] for j in range(len(IN_SIZES))]
        to_heads = lambda t: t.reshape(B_, S, ATTN_HEADS, ATTN_HEAD_DIM).transpose(0, 2, 1, 3)
        a = moba_attention(to_heads(aq), to_heads(ak), to_heads(av), t5_bias)
        a = a.transpose(0, 2, 1, 3).reshape(B_, S, ATTN_WIDTH)
        hshape = (B_, S, HGRN_HEADS, HGRN_HEAD_DIM)
        lb = lb_all[l].reshape(HGRN_HEADS, HGRN_HEAD_DIM)
        r = hgrn2(hq.reshape(hshape), hf.reshape(hshape), hi_.reshape(hshape), lb)
        r = r * lax.rsqrt(jnp.mean(jnp.square(r), axis=-1, keepdims=True) + RMS_EPS)
        r = r.reshape(B_, S, HGRN_WIDTH) * hgrn_norm_w[l].astype(jnp.float32)
        r = (r * jax.nn.sigmoid(hg.astype(jnp.float32))).astype(x.dtype)
        mix = jnp.einsum('bse,ed->bsd', jnp.concatenate([a, r], axis=-1), w_o[l])
        x = layer_norm(DEEPNORM_ALPHA * x + mix, ln1_g[l], ln1_b[l])
        moe = hier_moe(x, w_group[l], b_group[l], w_expert[l], b_expert[l], w_gate[l], w_up[l], w_down[l])
        x = layer_norm(DEEPNORM_ALPHA * x + moe, ln2_g[l], ln2_b[l])
    return x
```

```cpp
#include <hip/hip_runtime.h>
#include <cstdio>
#include <cstdint>

#define GAS __attribute__((address_space(1)))
#define LAS __attribute__((address_space(3)))
typedef unsigned short bf16;
typedef unsigned v4u __attribute__((ext_vector_type(4)));
typedef unsigned v2u __attribute__((ext_vector_type(2)));
typedef float f32x4 __attribute__((ext_vector_type(4)));
typedef GAS unsigned gu32;
#define RLX_AGENT __ATOMIC_RELAXED, __HIP_MEMORY_SCOPE_AGENT
#define LDS_WAIT() asm volatile("s_waitcnt lgkmcnt(0)" ::: "memory")
#define VM_WAIT() asm volatile("s_waitcnt vmcnt(0)" ::: "memory")

constexpr int NWAVES = 8, NT = 512;
constexpr int BATCH = 2, SEQ = 8192, D = 1024, T = BATCH * SEQ;
constexpr int NH = 8, HD = 64, AW = 512, INW = 3584;
constexpr int NBLK = 32, MBLK = 256;
constexpr int NE = 16, DE = 512;
constexpr float ALPHA = 1.189207115002721f;
constexpr float LN_EPS = 1e-5f, RMS_EPS = 1e-6f;

constexpr size_t MiB = 1u << 20;
constexpr size_t WS_CTL = 0, CTL_ZERO_BYTES = 1 * MiB;
constexpr size_t WS_KMEAN = 256 * 1024;
constexpr size_t WS_TAB = 1 * MiB;
constexpr size_t TAB_WR = 0, TAB_LB = 96 * 1024, TAB_BIAS = 100 * 1024;
constexpr size_t WS_WIN_T = 2 * MiB, WS_WO_T = 10 * MiB;
constexpr size_t WS_XB = 12 * MiB;
constexpr size_t WS_PROJ = 44 * MiB, PROJ_SLOT = 16 * MiB;
constexpr size_t WS_H = 44 * MiB, WS_YE = 80 * MiB;
constexpr size_t WS_AR = 156 * MiB;
constexpr size_t WS_LIST = 188 * MiB, WS_ML = 196 * MiB, WS_DECAY = 200 * MiB;
constexpr size_t WS_ROUTE = 201 * MiB;
constexpr size_t RT_TOKE = 0, RT_TOKW = 128 * 1024, RT_TOKP = 256 * 1024, RT_ELIST = 512 * 1024, RT_EW = 512 * 1024 + MiB;
constexpr size_t WS_WGU_T = 205 * MiB, WS_WD_T = 237 * MiB, WS_END = 253 * MiB;
constexpr int HROWS = 36864;
constexpr int CW_TMO = 0, CW_CODE = 1, CW_BAR = 4096, CW_ECNT = 8192, CW_LCNT = 8256;

constexpr int RING_BYTES = 131072, LDSCTL_OFF = RING_BYTES, MISC_OFF = LDSCTL_OFF + 320, LDS_BYTES = 147456;

__device__ __forceinline__ float bf2f(unsigned b) { return __builtin_bit_cast(float, b << 16); }
__device__ __forceinline__ unsigned f2bf(float f) { unsigned u = __builtin_bit_cast(unsigned, f); return (u + 0x7fffu + ((u >> 16) & 1u)) >> 16; }
__device__ __forceinline__ unsigned pk2(float lo, float hi) { return f2bf(lo) | (f2bf(hi) << 16); }
__device__ __forceinline__ float wave_sum(float v) {
#pragma unroll
    for (int o = 1; o < 64; o <<= 1) v += __shfl_xor(v, o);
    return v;
}
__device__ __forceinline__ float sigmoidf_(float x) { return 1.f / (1.f + __expf(-x)); }

#define XB_TMO      128
#define XB_XCNT(j)  (256  + 64 * (j))
#define XB_XSUB(j)  (1280 + 64 * (j))
#define XB_XGEN(j)  (2304 + 64 * (j))
#define XB_TOP      3328
#define XB_TOPGEN   3392
#define XCD_BAR_WORDS 3456
#define XB_SPIN_CAP (1u << 18)
__device__ __forceinline__ unsigned xb_ld(unsigned* p)              { return __hip_atomic_load(p, __ATOMIC_RELAXED, __HIP_MEMORY_SCOPE_AGENT); }
__device__ __forceinline__ unsigned xb_add(unsigned* p, unsigned v) { return __hip_atomic_fetch_add(p, v, __ATOMIC_RELAXED, __HIP_MEMORY_SCOPE_AGENT); }
__device__ __forceinline__ unsigned xb_xcc_id() { return (unsigned)__builtin_amdgcn_s_getreg((3 << 11) | 20) & 0xFu; }
#define XB_SPIN(cond, bar) do { unsigned _sp = 0; while (cond) { __builtin_amdgcn_s_sleep(1); \
    if ((++_sp & 255u) == 0u) { if (xb_ld(&(bar)[XB_TMO])) break; if (_sp > XB_SPIN_CAP) { atomicAdd(&(bar)[XB_TMO], 1u); break; } } } } while (0)
struct XcdBarrier { unsigned* bar; unsigned x; volatile LAS unsigned* st; };
__device__ __forceinline__ XcdBarrier xcd_barrier_post(unsigned* bar, volatile LAS unsigned* st) {
    XcdBarrier b; b.bar = bar; b.x = xb_xcc_id(); b.st = st;
    if (threadIdx.x == 0) (void)xb_add(&bar[XB_XCNT(b.x)], 1u);
    return b;
}
__device__ __forceinline__ void xcd_barrier_complete(unsigned* bar, unsigned x, unsigned& nloc, unsigned& nx) {
    const unsigned G = gridDim.x * gridDim.y * gridDim.z;
    unsigned sum, cnt, mine, sp = 0u;
    for (;;) {
        sum = 0u; cnt = 0u; mine = 0u;
#pragma unroll
        for (unsigned j = 0; j < 16; ++j) { const unsigned c = xb_ld(&bar[XB_XCNT(j)]); sum += c; cnt += (c > 0u) ? 1u : 0u; mine = (j == x) ? c : mine; }
        if (sum == G) break;
        __builtin_amdgcn_s_sleep(1);
        if ((++sp & 255u) == 0u) { if (xb_ld(&bar[XB_TMO])) break; if (sp > XB_SPIN_CAP) { atomicAdd(&bar[XB_TMO], 1u); break; } }
    }
    nloc = mine > 0u ? mine : 1u; nx = cnt > 0u ? cnt : 1u;
}
__device__ __forceinline__ void xcd_barrier(const XcdBarrier& b) {
    asm volatile("s_waitcnt vmcnt(0)" ::: "memory");
    __syncthreads();
    if (threadIdx.x == 0) {
        unsigned* bar = b.bar;
        __builtin_amdgcn_s_waitcnt(0);
        unsigned nloc = b.st[0], nx = b.st[1];
        if (nloc == 0u) { xcd_barrier_complete(bar, b.x, nloc, nx); b.st[0] = nloc; b.st[1] = nx; }
        const unsigned old = xb_add(&bar[XB_XSUB(b.x)], 1u);
        const unsigned gen = old / nloc;
        if (old + 1u == (gen + 1u) * nloc) {
            __builtin_amdgcn_fence(__ATOMIC_RELEASE, "agent");
            asm volatile("s_waitcnt vmcnt(0)" ::: "memory");
            const unsigned og = xb_add(&bar[XB_TOP], 1u);
            const unsigned tg = og / nx;
            if (og + 1u == (tg + 1u) * nx) xb_add(&bar[XB_TOPGEN], 1u);
            else XB_SPIN(xb_ld(&bar[XB_TOPGEN]) == tg, bar);
            __builtin_amdgcn_fence(__ATOMIC_ACQUIRE, "agent");
            xb_add(&bar[XB_XGEN(b.x)], 1u);
            asm volatile("s_waitcnt vmcnt(0)" ::: "memory");
        } else {
            XB_SPIN(xb_ld(&bar[XB_XGEN(b.x)]) == gen, bar);
            __builtin_amdgcn_fence(__ATOMIC_ACQUIRE, "agent");
            asm volatile("s_waitcnt vmcnt(0)" ::: "memory");
        }
    }
    __syncthreads();
}

struct Args { const float* in[17]; float* out; unsigned char* ws; int ph_lo, ph_hi; };
struct Frame {
    LAS unsigned char* lds;
    gu32* ctl;
    int tid, lane, wave, vcu, G;
    const Args* a;
};
#define F_IN(i) (F.a->in[i])
#define F_x F_IN(0)
#define F_w_in F_IN(1)
#define F_t5 F_IN(2)
#define F_lbl F_IN(3)
#define F_nw F_IN(4)
#define F_w_o F_IN(5)
#define F_ln1g F_IN(6)
#define F_ln1b F_IN(7)
#define F_w_grp F_IN(8)
#define F_b_grp F_IN(9)
#define F_w_exp F_IN(10)
#define F_b_exp F_IN(11)
#define F_w_gate F_IN(12)
#define F_w_up F_IN(13)
#define F_w_down F_IN(14)
#define F_ln2g F_IN(15)
#define F_ln2b F_IN(16)
#define F_out (F.a->out)
#define F_ws (F.a->ws)
#define F_KMEAN ((float*)(F_ws + WS_KMEAN))
#define F_WR ((float*)(F_ws + WS_TAB + TAB_WR))
#define F_LB ((float*)(F_ws + WS_TAB + TAB_LB))
#define F_BIASN ((float*)(F_ws + WS_TAB + TAB_BIAS))
#define F_WIN_T ((bf16*)(F_ws + WS_WIN_T))
#define F_WO_T ((bf16*)(F_ws + WS_WO_T))
#define F_WGU_T ((bf16*)(F_ws + WS_WGU_T))
#define F_WD_T ((bf16*)(F_ws + WS_WD_T))
#define F_XB ((bf16*)(F_ws + WS_XB))
#define F_X1B ((bf16*)(F_ws + WS_XB))
#define F_QB ((bf16*)(F_ws + WS_PROJ))
#define F_KB ((bf16*)(F_ws + WS_PROJ + PROJ_SLOT))
#define F_VT ((bf16*)(F_ws + WS_PROJ + 2 * PROJ_SLOT))
#define F_HQ ((bf16*)(F_ws + WS_PROJ + 3 * PROJ_SLOT))
#define F_HF ((bf16*)(F_ws + WS_PROJ + 4 * PROJ_SLOT))
#define F_HI ((bf16*)(F_ws + WS_PROJ + 5 * PROJ_SLOT))
#define F_HG ((bf16*)(F_ws + WS_PROJ + 6 * PROJ_SLOT))
#define F_AR ((bf16*)(F_ws + WS_AR))
#define F_HB ((bf16*)(F_ws + WS_H))
#define F_YE ((bf16*)(F_ws + WS_YE))
#define F_TOKE ((int*)(F_ws + WS_ROUTE + RT_TOKE))
#define F_TOKW ((float*)(F_ws + WS_ROUTE + RT_TOKW))
#define F_TOKP ((int*)(F_ws + WS_ROUTE + RT_TOKP))
#define F_ELIST ((int*)(F_ws + WS_ROUTE + RT_ELIST))
#define F_EW ((float*)(F_ws + WS_ROUTE + RT_EW))

template <class RM>
__device__ __forceinline__ void p0_transpose_item(const float* W, int K, int N, bf16* WT, LAS float* scr, int item, int lane, RM rm) {
    const int nblk = N / 32, kb = item / nblk, nb = item % nblk, k0 = 64 * kb, n0 = 32 * nb;
#pragma unroll 8
    for (int i = 0; i < 32; ++i) { const int kk = 2 * i + (lane >> 5); scr[kk * 33 + (lane & 31)] = W[(size_t)(k0 + kk) * N + n0 + (lane & 31)]; }
    LDS_WAIT(); asm volatile("" ::: "memory");
    const int c = lane & 7;
#pragma unroll
    for (int j = 0; j < 4; ++j) { const int n = (lane >> 3) + 8 * j; const LAS float* s = scr + (8 * c) * 33 + n;
        v4u o; o.x = pk2(s[0 * 33], s[1 * 33]); o.y = pk2(s[2 * 33], s[3 * 33]); o.z = pk2(s[4 * 33], s[5 * 33]); o.w = pk2(s[6 * 33], s[7 * 33]);
        *(GAS v4u*)(WT + (size_t)rm(n0 + n) * K + k0 + 8 * c) = o; }
    LDS_WAIT(); asm volatile("" ::: "memory");
}
__device__ __forceinline__ void p0_prologue(Frame& F) {
    LAS float* scr = (LAS float*)(F.lds + F.wave * 16384);
    const int gw = F.vcu * NWAVES + F.wave, NGW = F.G * NWAVES;
    constexpr int I_IN = 16 * 112, I_O = 16 * 32, I_G = 16 * 256, I_U = 16 * 256, I_D = 16 * 256;
    constexpr int NITEMS = I_IN + I_O + I_G + I_U + I_D;
    for (int it = gw; it < NITEMS; it += NGW) {
        int r = it;
        if (r < I_IN) { p0_transpose_item(F_w_in, D, INW, F_WIN_T, scr, r, F.lane, [](int n) { return n; }); continue; } r -= I_IN;
        if (r < I_O) { p0_transpose_item(F_w_o, D, D, F_WO_T, scr, r, F.lane, [](int n) { return n; }); continue; } r -= I_O;
        if (r < I_G) { const int e = r >> 8; p0_transpose_item(F_w_gate + (size_t)e * D * DE, D, DE, F_WGU_T + (size_t)e * 1024 * 1024, scr, r & 255, F.lane, [](int n) { return 256 * (n >> 7) + (n & 127); }); continue; } r -= I_G;
        if (r < I_U) { const int e = r >> 8; p0_transpose_item(F_w_up + (size_t)e * D * DE, D, DE, F_WGU_T + (size_t)e * 1024 * 1024, scr, r & 255, F.lane, [](int n) { return 256 * (n >> 7) + 128 + (n & 127); }); continue; } r -= I_U;
        { const int e = r >> 8; p0_transpose_item(F_w_down + (size_t)e * DE * D, DE, D, F_WD_T + (size_t)e * 1024 * 512, scr, r & 255, F.lane, [](int n) { return n; }); }
    }
    for (int m = gw; m < T; m += NGW) {
        const GAS f32x4* xr = (const GAS f32x4*)(F_x + (size_t)m * D) + F.lane;
        GAS v2u* o8 = (GAS v2u*)(F_XB + (size_t)m * D) + F.lane;
#pragma unroll
        for (int j = 0; j < 4; ++j) { const f32x4 v = xr[64 * j]; v2u o; o.x = pk2(v.x, v.y); o.y = pk2(v.z, v.w); o8[64 * j] = o; }
    }
    const int gt = blockIdx.x * NT + F.tid, NGT = F.G * NT;
    for (int i = gt; i < 1024 * 20; i += NGT) { const int c = i / 20, k = i % 20;
        F_WR[i] = (k < 4) ? F_w_grp[c * 4 + k] : F_w_exp[((size_t)((k - 4) >> 2) * 1024 + c) * 4 + ((k - 4) & 3)]; }
    for (int i = gt; i < 512; i += NGT) { const float l0 = F_lbl[i], l1 = F_lbl[512 + i]; F_LB[i] = 1.f / (1.f + __expf(l1 - l0)); }
    for (int i = gt; i < 8 * 128; i += NGT) { const int h = i >> 7, n = i & 127; int bk;
        if (n < 16) bk = n; else { bk = 16 + (int)(logf((float)n / 16.f) / logf(8.f) * 16.f); bk = bk > 31 ? 31 : bk; }
        F_BIASN[i] = F_t5[bk * 8 + h]; }
}

template <class AM, class BMp, class Epi>
__device__ __forceinline__ void naive_gemm(Frame& F, const bf16* A, int lda, int M, const bf16* Bt, int ldb, int ntn, int K, AM amap, BMp bmap, Epi epi) {
    LAS float* As = (LAS float*)F.lds; LAS float* Bs = As + 64 * 33;
    const int tilesM = (M + 63) / 64, ty = F.tid >> 4, tx = F.tid & 15;
    for (int tile = blockIdx.x; tile < tilesM * ntn; tile += F.G) {
        const int tm = tile / ntn, tn = tile % ntn;
        float acc[2][4];
#pragma unroll
        for (int i = 0; i < 2; ++i)
#pragma unroll
            for (int j = 0; j < 4; ++j) acc[i][j] = 0.f;
        for (int k0 = 0; k0 < K; k0 += 32) {
#pragma unroll
            for (int i = 0; i < 4; ++i) { const int idx = F.tid + 512 * i, r = idx >> 5, kk = idx & 31, gr = tm * 64 + r;
                float v = 0.f; if (gr < M) { const int ar = amap(gr); v = bf2f(A[(size_t)ar * lda + k0 + kk]); }
                As[r * 33 + kk] = v;
                Bs[r * 33 + kk] = bf2f(Bt[(size_t)bmap(tn, r) * ldb + k0 + kk]); }
            __syncthreads();
#pragma unroll 8
            for (int kk = 0; kk < 32; ++kk) { const float a0 = As[ty * 33 + kk], a1 = As[(ty + 32) * 33 + kk];
#pragma unroll
                for (int j = 0; j < 4; ++j) { const float b = Bs[(tx + 16 * j) * 33 + kk]; acc[0][j] += a0 * b; acc[1][j] += a1 * b; } }
            __syncthreads();
        }
        epi(tm, tn, ty, tx, acc);
    }
}

__device__ __forceinline__ void naive_kmean(Frame& F) {
    const int gt = blockIdx.x * NT + F.tid, NGT = F.G * NT;
    for (int i = gt; i < 16 * 32 * 64; i += NGT) { const int d = i & 63, j = (i >> 6) & 31, bh = i >> 11, b = bh >> 3, h = bh & 7;
        const bf16* p = F_KB + ((size_t)(b * SEQ + j * 256)) * AW + h * 64 + d; float s = 0.f;
        for (int t = 0; t < 256; ++t) s += bf2f(p[(size_t)t * AW]);
        F_KMEAN[i] = s; }
}
__device__ __forceinline__ void naive_attn(Frame& F) {
    const int NGT = F.G * NT;
    for (int gi = blockIdx.x * NT + F.tid; gi < 16 * SEQ; gi += NGT) {
        const int bh = gi >> 13, qi = gi & 8191, b = bh >> 3, h = bh & 7, n = qi >> 8;
        float q[64];
        { const GAS v4u* qp = (const GAS v4u*)(F_QB + ((size_t)(b * SEQ + qi)) * AW + h * 64);
#pragma unroll
          for (int c = 0; c < 8; ++c) { const v4u w = qp[c];
              q[8*c+0] = bf2f(w.x & 0xffff); q[8*c+1] = bf2f(w.x >> 16); q[8*c+2] = bf2f(w.y & 0xffff); q[8*c+3] = bf2f(w.y >> 16);
              q[8*c+4] = bf2f(w.z & 0xffff); q[8*c+5] = bf2f(w.z >> 16); q[8*c+6] = bf2f(w.w & 0xffff); q[8*c+7] = bf2f(w.w >> 16); } }
        int s0 = -1, s1 = -1, s2 = -1;
        const float* km = F_KMEAN + (size_t)bh * 32 * 64;
        for (int pass = 0; pass < 3; ++pass) {
            float best = -INFINITY; int bi = -1;
            for (int j = 0; j < n; ++j) { if (j == s0 || j == s1) continue; float g = 0.f;
#pragma unroll
                for (int d = 0; d < 64; ++d) g += q[d] * km[j * 64 + d];
                if (g > best) { best = g; bi = j; } }
            if (pass == 0) s0 = bi; else if (pass == 1) s1 = bi; else s2 = bi;
        }
        float m = -INFINITY, l = 0.f, o[64];
#pragma unroll
        for (int d = 0; d < 64; ++d) o[d] = 0.f;
        const float* bias = F_BIASN + h * 128;
        for (int bsel = 0; bsel < 4; ++bsel) {
            const int blk = bsel == 0 ? s0 : bsel == 1 ? s1 : bsel == 2 ? s2 : n;
            if (blk < 0) continue;
            const int ngrp = (bsel == 3) ? ((qi & 255) >> 3) + 1 : 32;
            for (int kg = 0; kg < ngrp; ++kg) {
                const int kp0 = blk * 256 + kg * 8; float s[8]; float gm = -INFINITY;
#pragma unroll
                for (int u = 0; u < 8; ++u) { const int kpos = kp0 + u;
                    const GAS v4u* kp = (const GAS v4u*)(F_KB + ((size_t)(b * SEQ + kpos)) * AW + h * 64); float dt = 0.f;
#pragma unroll
                    for (int c = 0; c < 8; ++c) { const v4u w = kp[c];
                        dt += q[8*c+0] * bf2f(w.x & 0xffff) + q[8*c+1] * bf2f(w.x >> 16) + q[8*c+2] * bf2f(w.y & 0xffff) + q[8*c+3] * bf2f(w.y >> 16)
                            + q[8*c+4] * bf2f(w.z & 0xffff) + q[8*c+5] * bf2f(w.z >> 16) + q[8*c+6] * bf2f(w.w & 0xffff) + q[8*c+7] * bf2f(w.w >> 16); }
                    const int dist = qi - kpos;
                    s[u] = (dist >= 0) ? dt * 0.125f + bias[dist > 127 ? 127 : dist] : -INFINITY;
                    gm = fmaxf(gm, s[u]); }
                const float mn = fmaxf(m, gm); const float alpha = __expf(m - mn); float p[8]; float ps = 0.f;
#pragma unroll
                for (int u = 0; u < 8; ++u) { p[u] = __expf(s[u] - mn); ps += p[u]; }
                l = l * alpha + ps; m = mn;
                const GAS v4u* vp = (const GAS v4u*)(F_VT + ((size_t)bh * 64) * SEQ + kp0);
#pragma unroll
                for (int d = 0; d < 64; ++d) { const v4u w = vp[(size_t)d * (SEQ / 8)];
                    o[d] = o[d] * alpha + p[0] * bf2f(w.x & 0xffff) + p[1] * bf2f(w.x >> 16) + p[2] * bf2f(w.y & 0xffff) + p[3] * bf2f(w.y >> 16)
                         + p[4] * bf2f(w.z & 0xffff) + p[5] * bf2f(w.z >> 16) + p[6] * bf2f(w.w & 0xffff) + p[7] * bf2f(w.w >> 16); }
            }
        }
        const float inv = 1.f / l;
        GAS unsigned* op = (GAS unsigned*)(F_AR + ((size_t)(b * SEQ + qi)) * D + h * 64);
#pragma unroll
        for (int d = 0; d < 64; d += 2) op[d >> 1] = pk2(o[d] * inv, o[d + 1] * inv);
    }
}
__device__ __forceinline__ void naive_hgrn(Frame& F) {
    if (F.wave != 0) return;
    for (int bh = blockIdx.x; bh < 16; bh += F.G) {
        const int b = bh >> 3, h = bh & 7, lane = F.lane;
        const float lb = F_LB[h * 64 + lane], nwv = F_nw[h * 64 + lane];
        float S[64];
#pragma unroll
        for (int k = 0; k < 64; ++k) S[k] = 0.f;
        LAS float* bc = (LAS float*)F.lds;
        for (int t0 = 0; t0 < SEQ; t0 += 8) {
#pragma unroll
            for (int u = 0; u < 8; ++u) { const size_t off = ((size_t)(b * SEQ + t0 + u)) * AW + h * 64 + lane;
                const float fl = bf2f(F_HF[off]), ql = bf2f(F_HQ[off]), vl = bf2f(F_HI[off]), gl = bf2f(F_HG[off]);
                const float f = lb + (1.f - lb) * sigmoidf_(fl);
                bc[u * 320 + lane] = f; bc[u * 320 + 64 + lane] = 1.f - f; bc[u * 320 + 128 + lane] = ql * sigmoidf_(ql);
                bc[u * 320 + 192 + lane] = vl; bc[u * 320 + 256 + lane] = sigmoidf_(gl); }
            LDS_WAIT(); asm volatile("" ::: "memory");
#pragma unroll 1
            for (int u = 0; u < 8; ++u) {
                const LAS float* pb = bc + u * 320;
                const float vv = pb[192 + lane], gs = pb[256 + lane];
                float o = 0.f;
#pragma unroll
                for (int k = 0; k < 64; k += 4) {
                    const f32x4 f4 = *(const LAS f32x4*)(pb + k), k4 = *(const LAS f32x4*)(pb + 64 + k), q4 = *(const LAS f32x4*)(pb + 128 + k);
                    S[k] = f4.x * S[k] + k4.x * vv; o += q4.x * S[k];
                    S[k + 1] = f4.y * S[k + 1] + k4.y * vv; o += q4.y * S[k + 1];
                    S[k + 2] = f4.z * S[k + 2] + k4.z * vv; o += q4.z * S[k + 2];
                    S[k + 3] = f4.w * S[k + 3] + k4.w * vv; o += q4.w * S[k + 3];
                    if ((k & 15) == 12) __builtin_amdgcn_sched_barrier(0); }
                const float ms = wave_sum(o * o) * (1.f / 64.f);
                const float r = o * rsqrtf(ms + RMS_EPS) * nwv * gs;
                F_AR[((size_t)(b * SEQ + t0 + u)) * D + AW + h * 64 + lane] = (bf16)f2bf(r);
            }
            LDS_WAIT(); asm volatile("" ::: "memory");
        }
    }
}

__device__ __forceinline__ void seg_bases(Frame& F, int (&base)[16], int (&cnt)[16]) {
    int acc = 0;
#pragma unroll
    for (int e = 0; e < 16; ++e) { cnt[e] = (int)F.ctl[CW_ECNT + e]; base[e] = acc; acc += (cnt[e] + 255) & ~255; }
}
__device__ __forceinline__ void p6_ln1_router(Frame& F) {
    LAS int* rinfo = (LAS int*)F.lds;
    LAS int* lcnt = rinfo + 256;
    LAS int* gbase = lcnt + 16;
    LAS int* lpos = gbase + 16;
    float* Y = F_out;
    for (int grp = F.vcu; grp < T / 64; grp += F.G) {
        if (F.tid < 16) lcnt[F.tid] = 0;
        __syncthreads();
        for (int i = 0; i < 8; ++i) {
            const int rl = F.wave * 8 + i, m = grp * 64 + rl;
            GAS f32x4* yr = (GAS f32x4*)(Y + (size_t)m * D) + F.lane;
            f32x4 v[4]; float s = 0.f;
#pragma unroll
            for (int j = 0; j < 4; ++j) { v[j] = yr[64 * j]; s += (v[j].x + v[j].y) + (v[j].z + v[j].w); }
            const float mean = wave_sum(s) * (1.f / D); float s2 = 0.f;
#pragma unroll
            for (int j = 0; j < 4; ++j) { v[j] = v[j] - mean; s2 += (v[j].x * v[j].x + v[j].y * v[j].y) + (v[j].z * v[j].z + v[j].w * v[j].w); }
            const float rstd = rsqrtf(wave_sum(s2) * (1.f / D) + LN_EPS);
            GAS v2u* o8 = (GAS v2u*)(F_X1B + (size_t)m * D) + F.lane;
            float racc[20];
#pragma unroll
            for (int k = 0; k < 20; ++k) racc[k] = 0.f;
#pragma unroll
            for (int j = 0; j < 4; ++j) { const int c0 = 4 * F.lane + 256 * j;
                const f32x4 g = *(const GAS f32x4*)(F_ln1g + c0), bb = *(const GAS f32x4*)(F_ln1b + c0);
                v[j] = v[j] * rstd * g + bb;
                yr[64 * j] = v[j]; v2u o; o.x = pk2(v[j].x, v[j].y); o.y = pk2(v[j].z, v[j].w); o8[64 * j] = o;
#pragma unroll
                for (int ii = 0; ii < 4; ++ii) { const GAS f32x4* wr = (const GAS f32x4*)(F_WR + (size_t)(c0 + ii) * 20); const float xv = v[j][ii];
#pragma unroll
                    for (int k4 = 0; k4 < 5; ++k4) { const f32x4 w = wr[k4]; racc[4*k4+0] += xv * w.x; racc[4*k4+1] += xv * w.y; racc[4*k4+2] += xv * w.z; racc[4*k4+3] += xv * w.w; } } }
#pragma unroll
            for (int k = 0; k < 20; ++k) racc[k] = wave_sum(racc[k]);
            if (F.lane == 0) {
                float gl[4]; int gi = 0; float gmx = -INFINITY;
#pragma unroll
                for (int g = 0; g < 4; ++g) { gl[g] = racc[g] + F_b_grp[g]; if (gl[g] > gmx) { gmx = gl[g]; gi = g; } }
                float gs = 0.f;
#pragma unroll
                for (int g = 0; g < 4; ++g) gs += __expf(gl[g] - gmx);
                const float gw = 1.f / gs;
                float el[4];
#pragma unroll
                for (int e = 0; e < 4; ++e) { float a = 0.f;
#pragma unroll
                    for (int g = 0; g < 4; ++g) a = (g == gi) ? racc[4 + 4 * g + e] : a;
                    el[e] = a + F_b_exp[gi * 4 + e]; }
                int e0 = 0; float m0 = -INFINITY;
#pragma unroll
                for (int e = 0; e < 4; ++e) if (el[e] > m0) { m0 = el[e]; e0 = e; }
                int e1 = 0; float m1 = -INFINITY;
#pragma unroll
                for (int e = 0; e < 4; ++e) if (e != e0 && el[e] > m1) { m1 = el[e]; e1 = e; }
                const float p1 = __expf(m1 - m0), w0 = gw / (1.f + p1), w1 = gw * p1 / (1.f + p1);
                rinfo[rl * 4 + 0] = gi * 4 + e0; rinfo[rl * 4 + 1] = gi * 4 + e1;
                rinfo[rl * 4 + 2] = __builtin_bit_cast(int, w0); rinfo[rl * 4 + 3] = __builtin_bit_cast(int, w1);
            }
        }
        __syncthreads();
        if (F.tid < 128) { const int rl = F.tid >> 1, s = F.tid & 1; lpos[F.tid] = atomicAdd((int*)&lcnt[rinfo[rl * 4 + s]], 1); }
        __syncthreads();
        if (F.tid < 16) gbase[F.tid] = (int)__hip_atomic_fetch_add(F.ctl + CW_ECNT + F.tid, (unsigned)lcnt[F.tid], RLX_AGENT);
        __syncthreads();
        if (F.tid < 128) { const int rl = F.tid >> 1, s = F.tid & 1, e = rinfo[rl * 4 + s], pos = gbase[e] + lpos[F.tid], m = grp * 64 + rl;
            const float w = __builtin_bit_cast(float, rinfo[rl * 4 + 2 + s]);
            F_ELIST[(size_t)e * T + pos] = m; F_EW[(size_t)e * T + pos] = w;
            F_TOKE[m * 2 + s] = e; F_TOKP[m * 2 + s] = pos; F_TOKW[m * 2 + s] = w; }
        __syncthreads();
    }
}
__device__ __forceinline__ void p9_final(Frame& F) {
    int base[16], cnt[16]; seg_bases(F, base, cnt);
    const int gw = F.vcu * NWAVES + F.wave, NGW = F.G * NWAVES;
    for (int m = gw; m < T; m += NGW) {
        int r0 = 0, r1 = 0; { const int e0 = F_TOKE[m * 2], e1 = F_TOKE[m * 2 + 1], p0 = F_TOKP[m * 2], p1 = F_TOKP[m * 2 + 1];
#pragma unroll
            for (int e = 0; e < 16; ++e) { r0 = (e == e0) ? base[e] + p0 : r0; r1 = (e == e1) ? base[e] + p1 : r1; } }
        GAS f32x4* xr = (GAS f32x4*)(F_out + (size_t)m * D) + F.lane;
        const GAS v2u* y0 = (const GAS v2u*)(F_YE + (size_t)r0 * D) + F.lane; const GAS v2u* y1 = (const GAS v2u*)(F_YE + (size_t)r1 * D) + F.lane;
        f32x4 v[4]; float s = 0.f;
#pragma unroll
        for (int j = 0; j < 4; ++j) { const f32x4 xv = xr[64 * j]; const v2u a = y0[64 * j], c = y1[64 * j];
            v[j].x = ALPHA * xv.x + bf2f(a.x & 0xffff) + bf2f(c.x & 0xffff); v[j].y = ALPHA * xv.y + bf2f(a.x >> 16) + bf2f(c.x >> 16);
            v[j].z = ALPHA * xv.z + bf2f(a.y & 0xffff) + bf2f(c.y & 0xffff); v[j].w = ALPHA * xv.w + bf2f(a.y >> 16) + bf2f(c.y >> 16);
            s += (v[j].x + v[j].y) + (v[j].z + v[j].w); }
        const float mean = wave_sum(s) * (1.f / D); float s2 = 0.f;
#pragma unroll
        for (int j = 0; j < 4; ++j) { v[j] = v[j] - mean; s2 += (v[j].x * v[j].x + v[j].y * v[j].y) + (v[j].z * v[j].z + v[j].w * v[j].w); }
        const float rstd = rsqrtf(wave_sum(s2) * (1.f / D) + LN_EPS);
#pragma unroll
        for (int j = 0; j < 4; ++j) { const int c0 = 4 * F.lane + 256 * j;
            const f32x4 g = *(const GAS f32x4*)(F_ln2g + c0), bb = *(const GAS f32x4*)(F_ln2b + c0);
            xr[64 * j] = v[j] * rstd * g + bb; }
    }
}

constexpr int NPHASE = 10;
__global__ void __launch_bounds__(NT, 2) fwd(Args args) {
    extern __shared__ __attribute__((aligned(16))) unsigned char lds[];
    Frame F;
    F.lds = (LAS unsigned char*)lds;
    F.tid = threadIdx.x; F.lane = F.tid & 63; F.wave = __builtin_amdgcn_readfirstlane(F.tid >> 6);
    F.G = gridDim.x; { const int bx = blockIdx.x; F.vcu = (F.G % 8 == 0) ? (bx % 8) * (F.G / 8) + bx / 8 : bx; }
    F.a = &args;
    F.ctl = (gu32*)(args.ws + WS_CTL);
    for (int u = F.tid; u < (LDS_BYTES - LDSCTL_OFF) / 4; u += NT) ((LAS unsigned*)(F.lds + LDSCTL_OFF))[u] = 0u;
    __syncthreads();
    XcdBarrier bar = xcd_barrier_post((unsigned*)(F.ctl + CW_BAR), (volatile LAS unsigned*)(F.lds + MISC_OFF) + 8);
    const int lo = args.ph_lo, hi = args.ph_hi;
#define IN(k) (lo <= (k) && (k) < hi)
#define SEAM(k) do { if (IN(k) && IN((k) + 1)) xcd_barrier(bar); } while (0)

    if (IN(0)) { p0_prologue(F); } SEAM(0);
    if (IN(1)) {
        naive_gemm(F, F_XB, D, T, F_WIN_T, D, INW / 64, D, [](int r) { return r; }, [](int tn, int c) { return tn * 64 + c; },
            [&](int tm, int tn, int ty, int tx, float (&acc)[2][4]) {
#pragma unroll
                for (int i = 0; i < 2; ++i)
#pragma unroll
                    for (int j = 0; j < 4; ++j) { const int row = tm * 64 + ty + 32 * i, col = tn * 64 + tx + 16 * j, grp = col >> 9, cc = col & 511;
                        const bf16 v = (bf16)f2bf(acc[i][j]);
                        if (grp == 2) { const int b = row >> 13, t = row & 8191; F_VT[((size_t)(b * 8 + (cc >> 6)) * 64 + (cc & 63)) * SEQ + t] = v; }
                        else ((bf16*)(F_ws + WS_PROJ + (size_t)grp * PROJ_SLOT))[(size_t)row * AW + cc] = v; }
            });
    } SEAM(1);
    if (IN(2)) { naive_kmean(F); } SEAM(2);
    if (IN(3)) { naive_attn(F); naive_hgrn(F); } SEAM(3);
    if (IN(4)) { } SEAM(4);
    if (IN(5)) {
        naive_gemm(F, F_AR, D, T, F_WO_T, D, D / 64, D, [](int r) { return r; }, [](int tn, int c) { return tn * 64 + c; },
            [&](int tm, int tn, int ty, int tx, float (&acc)[2][4]) {
#pragma unroll
                for (int i = 0; i < 2; ++i)
#pragma unroll
                    for (int j = 0; j < 4; ++j) { const size_t o = (size_t)(tm * 64 + ty + 32 * i) * D + tn * 64 + tx + 16 * j; F_out[o] = ALPHA * F_x[o] + acc[i][j]; }
            });
    } SEAM(5);
    if (IN(6)) { p6_ln1_router(F); } SEAM(6);
    if (IN(7)) {
        int base[16], cnt[16]; seg_bases(F, base, cnt);
        for (int e = 0; e < 16; ++e) {
            const int* el = F_ELIST + (size_t)e * T; const int be = base[e], ce = cnt[e];
            naive_gemm(F, F_X1B, D, ce, F_WGU_T + (size_t)e * 1024 * 1024, D, DE / 32, D, [&](int r) { return el[r]; },
                [](int tn, int c) { const int j = tn * 32 + (c & 31); return 256 * (j >> 7) + (j & 127) + ((c >> 5) ? 128 : 0); },
                [&](int tm, int tn, int ty, int tx, float (&acc)[2][4]) {
#pragma unroll
                    for (int i = 0; i < 2; ++i)
#pragma unroll
                        for (int j = 0; j < 2; ++j) { const int row = tm * 64 + ty + 32 * i; if (row < ce) { const float g = acc[i][j], u = acc[i][j + 2];
                            F_HB[(size_t)(be + row) * DE + tn * 32 + tx + 16 * j] = (bf16)f2bf(g * sigmoidf_(g) * u); } }
                });
        }
    } SEAM(7);
    if (IN(8)) {
        int base[16], cnt[16]; seg_bases(F, base, cnt);
        for (int e = 0; e < 16; ++e) {
            const int be = base[e], ce = cnt[e]; const float* ew = F_EW + (size_t)e * T;
            naive_gemm(F, F_HB + (size_t)be * DE, DE, ce, F_WD_T + (size_t)e * 1024 * 512, DE, D / 64, DE, [](int r) { return r; }, [](int tn, int c) { return tn * 64 + c; },
                [&](int tm, int tn, int ty, int tx, float (&acc)[2][4]) {
#pragma unroll
                    for (int i = 0; i < 2; ++i)
#pragma unroll
                        for (int j = 0; j < 4; ++j) { const int row = tm * 64 + ty + 32 * i; if (row < ce)
                            F_YE[(size_t)(be + row) * D + tn * 64 + tx + 16 * j] = (bf16)f2bf(acc[i][j] * ew[row]); }
                });
        }
    } SEAM(8);
    if (IN(9)) { p9_final(F); }
#undef IN
#undef SEAM
}

extern "C" void kernel_launch(void* const* d_in, const int* in_sizes, int n_in, void* d_out, int out_size, void* d_ws, size_t ws_size, hipStream_t stream) {
    static int grid = 0;
    if (grid == 0) {
        if (n_in != 17 || in_sizes[0] != T * D || out_size != T * D || ws_size < WS_END) { fprintf(stderr, "kernel_launch: unexpected shapes (n_in %d, in0 %d, out %d, ws %zu)\n", n_in, n_in > 0 ? in_sizes[0] : -1, out_size, ws_size); grid = -1; return; }
        int dev = 0, cus = 0;
        if (hipGetDevice(&dev) != hipSuccess || hipDeviceGetAttribute(&cus, hipDeviceAttributeMultiprocessorCount, dev) != hipSuccess) { grid = -1; return; }
        if (hipFuncSetAttribute((const void*)fwd, hipFuncAttributeMaxDynamicSharedMemorySize, LDS_BYTES) != hipSuccess) { fprintf(stderr, "kernel_launch: hipFuncSetAttribute failed\n"); grid = -1; return; }
        (void)hipGetLastError();
        grid = cus;
    }
    if (grid < 0) return;
    if (hipMemsetAsync((char*)d_ws + WS_CTL, 0, CTL_ZERO_BYTES, stream) != hipSuccess) return;
    Args a{};
    for (int i = 0; i < 17; ++i) a.in[i] = (const float*)d_in[i];
    a.out = (float*)d_out; a.ws = (unsigned char*)d_ws; a.ph_lo = 0; a.ph_hi = NPHASE;
    hipLaunchKernelGGL(fwd, dim3(grid), dim3(NT), LDS_BYTES, stream, a);
}
```

```cpp
#include <hip/hip_runtime.h>
#include <cstdio>
#include <cstdint>

#define GAS __attribute__((address_space(1)))
#define LAS __attribute__((address_space(3)))
typedef unsigned short bf16;
typedef unsigned v4u __attribute__((ext_vector_type(4)));
typedef unsigned v2u __attribute__((ext_vector_type(2)));
typedef float f32x4 __attribute__((ext_vector_type(4)));
typedef float f32x2 __attribute__((ext_vector_type(2)));
typedef GAS unsigned gu32;
#define RLX_AGENT __ATOMIC_RELAXED, __HIP_MEMORY_SCOPE_AGENT
#define LDS_WAIT() asm volatile("s_waitcnt lgkmcnt(0)" ::: "memory")
#define VM_WAIT() asm volatile("s_waitcnt vmcnt(0)" ::: "memory")

#ifndef OPT_GEMM
#define OPT_GEMM 1
#endif
#ifndef OPT_ATTN
#define OPT_ATTN 1
#endif
#ifndef OPT_HGRN
#define OPT_HGRN 1
#endif
constexpr int NWAVES = 8, NT = 512;
constexpr int BATCH = 2, SEQ = 8192, D = 1024, T = BATCH * SEQ;
constexpr int NH = 8, HD = 64, AW = 512, INW = 3584;
constexpr int NBLK = 32, MBLK = 256;
constexpr int NE = 16, DE = 512;
constexpr float ALPHA = 1.189207115002721f;
constexpr float LN_EPS = 1e-5f, RMS_EPS = 1e-6f;

constexpr size_t MiB = 1u << 20;
constexpr size_t WS_CTL = 0, CTL_ZERO_BYTES = 1 * MiB;
constexpr size_t WS_KMEAN = 256 * 1024;
constexpr size_t WS_TAB = 1 * MiB;
constexpr size_t TAB_WR = 0, TAB_LB = 96 * 1024, TAB_BIAS = 100 * 1024;
constexpr size_t WS_WIN_T = 2 * MiB, WS_WO_T = 10 * MiB;
constexpr size_t WS_XB = 12 * MiB;
constexpr size_t WS_PROJ = 44 * MiB, PROJ_SLOT = 16 * MiB;
constexpr size_t WS_H = 44 * MiB, WS_YE = 80 * MiB;
constexpr size_t WS_AR = 156 * MiB;
constexpr size_t WS_LIST = 188 * MiB, WS_ML = 196 * MiB, WS_DECAY = 200 * MiB;
constexpr size_t WS_ROUTE = 201 * MiB;
constexpr size_t RT_TOKE = 0, RT_TOKW = 128 * 1024, RT_TOKP = 256 * 1024, RT_ELIST = 512 * 1024, RT_EW = 512 * 1024 + MiB;
constexpr size_t WS_WGU_T = 205 * MiB, WS_WD_T = 237 * MiB, WS_END = 253 * MiB;
constexpr int HROWS = 36864;
constexpr int CW_TMO = 0, CW_CODE = 1, CW_BAR = 4096, CW_ECNT = 8192, CW_LCNT = 8256;

constexpr int RING_BYTES = 131072, LDSCTL_OFF = RING_BYTES, MISC_OFF = LDSCTL_OFF + 320, LDS_BYTES = 147456;

__device__ __forceinline__ float bf2f(unsigned b) { return __builtin_bit_cast(float, b << 16); }
__device__ __forceinline__ unsigned f2bf(float f) { unsigned u = __builtin_bit_cast(unsigned, f); return (u + 0x7fffu + ((u >> 16) & 1u)) >> 16; }
__device__ __forceinline__ unsigned pk2(float lo, float hi) { return f2bf(lo) | (f2bf(hi) << 16); }
__device__ __forceinline__ float wave_sum(float v) {
#pragma unroll
    for (int o = 1; o < 64; o <<= 1) v += __shfl_xor(v, o);
    return v;
}
__device__ __forceinline__ float sigmoidf_(float x) { return 1.f / (1.f + __expf(-x)); }

#define XB_TMO      128
#define XB_XCNT(j)  (256  + 64 * (j))
#define XB_XSUB(j)  (1280 + 64 * (j))
#define XB_XGEN(j)  (2304 + 64 * (j))
#define XB_TOP      3328
#define XB_TOPGEN   3392
#define XCD_BAR_WORDS 3456
#define XB_SPIN_CAP (1u << 18)
__device__ __forceinline__ unsigned xb_ld(unsigned* p)              { return __hip_atomic_load(p, __ATOMIC_RELAXED, __HIP_MEMORY_SCOPE_AGENT); }
__device__ __forceinline__ unsigned xb_add(unsigned* p, unsigned v) { return __hip_atomic_fetch_add(p, v, __ATOMIC_RELAXED, __HIP_MEMORY_SCOPE_AGENT); }
__device__ __forceinline__ unsigned xb_xcc_id() { return (unsigned)__builtin_amdgcn_s_getreg((3 << 11) | 20) & 0xFu; }
#define XB_SPIN(cond, bar) do { unsigned _sp = 0; while (cond) { __builtin_amdgcn_s_sleep(1); \
    if ((++_sp & 255u) == 0u) { if (xb_ld(&(bar)[XB_TMO])) break; if (_sp > XB_SPIN_CAP) { atomicAdd(&(bar)[XB_TMO], 1u); break; } } } } while (0)
struct XcdBarrier { unsigned* bar; unsigned x; volatile LAS unsigned* st; };
__device__ __forceinline__ XcdBarrier xcd_barrier_post(unsigned* bar, volatile LAS unsigned* st) {
    XcdBarrier b; b.bar = bar; b.x = xb_xcc_id(); b.st = st;
    if (threadIdx.x == 0) (void)xb_add(&bar[XB_XCNT(b.x)], 1u);
    return b;
}
__device__ __forceinline__ void xcd_barrier_complete(unsigned* bar, unsigned x, unsigned& nloc, unsigned& nx) {
    const unsigned G = gridDim.x * gridDim.y * gridDim.z;
    unsigned sum, cnt, mine, sp = 0u;
    for (;;) {
        sum = 0u; cnt = 0u; mine = 0u;
#pragma unroll
        for (unsigned j = 0; j < 16; ++j) { const unsigned c = xb_ld(&bar[XB_XCNT(j)]); sum += c; cnt += (c > 0u) ? 1u : 0u; mine = (j == x) ? c : mine; }
        if (sum == G) break;
        __builtin_amdgcn_s_sleep(1);
        if ((++sp & 255u) == 0u) { if (xb_ld(&bar[XB_TMO])) break; if (sp > XB_SPIN_CAP) { atomicAdd(&bar[XB_TMO], 1u); break; } }
    }
    nloc = mine > 0u ? mine : 1u; nx = cnt > 0u ? cnt : 1u;
}
__device__ __forceinline__ void xcd_barrier(const XcdBarrier& b) {
    asm volatile("s_waitcnt vmcnt(0)" ::: "memory");
    __syncthreads();
    if (threadIdx.x == 0) {
        unsigned* bar = b.bar;
        __builtin_amdgcn_s_waitcnt(0);
        unsigned nloc = b.st[0], nx = b.st[1];
        if (nloc == 0u) { xcd_barrier_complete(bar, b.x, nloc, nx); b.st[0] = nloc; b.st[1] = nx; }
        const unsigned old = xb_add(&bar[XB_XSUB(b.x)], 1u);
        const unsigned gen = old / nloc;
        if (old + 1u == (gen + 1u) * nloc) {
            __builtin_amdgcn_fence(__ATOMIC_RELEASE, "agent");
            asm volatile("s_waitcnt vmcnt(0)" ::: "memory");
            const unsigned og = xb_add(&bar[XB_TOP], 1u);
            const unsigned tg = og / nx;
            if (og + 1u == (tg + 1u) * nx) xb_add(&bar[XB_TOPGEN], 1u);
            else XB_SPIN(xb_ld(&bar[XB_TOPGEN]) == tg, bar);
            __builtin_amdgcn_fence(__ATOMIC_ACQUIRE, "agent");
            xb_add(&bar[XB_XGEN(b.x)], 1u);
            asm volatile("s_waitcnt vmcnt(0)" ::: "memory");
        } else {
            XB_SPIN(xb_ld(&bar[XB_XGEN(b.x)]) == gen, bar);
            __builtin_amdgcn_fence(__ATOMIC_ACQUIRE, "agent");
            asm volatile("s_waitcnt vmcnt(0)" ::: "memory");
        }
    }
    __syncthreads();
}

struct Args { const float* in[17]; float* out; unsigned char* ws; int ph_lo, ph_hi; };
struct Frame {
    LAS unsigned char* lds;
    gu32* ctl;
    int tid, lane, wave, vcu, G;
    const Args* a;
};
#define F_IN(i) (F.a->in[i])
#define F_x F_IN(0)
#define F_w_in F_IN(1)
#define F_t5 F_IN(2)
#define F_lbl F_IN(3)
#define F_nw F_IN(4)
#define F_w_o F_IN(5)
#define F_ln1g F_IN(6)
#define F_ln1b F_IN(7)
#define F_w_grp F_IN(8)
#define F_b_grp F_IN(9)
#define F_w_exp F_IN(10)
#define F_b_exp F_IN(11)
#define F_w_gate F_IN(12)
#define F_w_up F_IN(13)
#define F_w_down F_IN(14)
#define F_ln2g F_IN(15)
#define F_ln2b F_IN(16)
#define F_out (F.a->out)
#define F_ws (F.a->ws)
#define F_KMEAN ((float*)(F_ws + WS_KMEAN))
#define F_WR ((float*)(F_ws + WS_TAB + TAB_WR))
#define F_LB ((float*)(F_ws + WS_TAB + TAB_LB))
#define F_BIASN ((float*)(F_ws + WS_TAB + TAB_BIAS))
#define F_WIN_T ((bf16*)(F_ws + WS_WIN_T))
#define F_WO_T ((bf16*)(F_ws + WS_WO_T))
#define F_WGU_T ((bf16*)(F_ws + WS_WGU_T))
#define F_WD_T ((bf16*)(F_ws + WS_WD_T))
#define F_XB ((bf16*)(F_ws + WS_XB))
#define F_X1B ((bf16*)(F_ws + WS_XB))
#define F_QB ((bf16*)(F_ws + WS_PROJ))
#define F_KB ((bf16*)(F_ws + WS_PROJ + PROJ_SLOT))
#define F_VT ((bf16*)(F_ws + WS_PROJ + 2 * PROJ_SLOT))
#define F_HQ ((bf16*)(F_ws + WS_PROJ + 3 * PROJ_SLOT))
#define F_HF ((bf16*)(F_ws + WS_PROJ + 4 * PROJ_SLOT))
#define F_HI ((bf16*)(F_ws + WS_PROJ + 5 * PROJ_SLOT))
#define F_HG ((bf16*)(F_ws + WS_PROJ + 6 * PROJ_SLOT))
#define F_AR ((bf16*)(F_ws + WS_AR))
#define F_HB ((bf16*)(F_ws + WS_H))
#define F_YE ((bf16*)(F_ws + WS_YE))
#define F_TOKE ((int*)(F_ws + WS_ROUTE + RT_TOKE))
#define F_TOKW ((float*)(F_ws + WS_ROUTE + RT_TOKW))
#define F_TOKP ((int*)(F_ws + WS_ROUTE + RT_TOKP))
#define F_ELIST ((int*)(F_ws + WS_ROUTE + RT_ELIST))
#define F_EW ((float*)(F_ws + WS_ROUTE + RT_EW))

template <class RM>
__device__ __forceinline__ void p0_transpose_item(const float* W, int K, int N, bf16* WT, LAS float* scr, int item, int lane, RM rm) {
    const int nblk = N / 32, kb = item / nblk, nb = item % nblk, k0 = 64 * kb, n0 = 32 * nb;
#pragma unroll 8
    for (int i = 0; i < 32; ++i) { const int kk = 2 * i + (lane >> 5); scr[kk * 33 + (lane & 31)] = W[(size_t)(k0 + kk) * N + n0 + (lane & 31)]; }
    LDS_WAIT(); asm volatile("" ::: "memory");
    const int c = lane & 7;
#pragma unroll
    for (int j = 0; j < 4; ++j) { const int n = (lane >> 3) + 8 * j; const LAS float* s = scr + (8 * c) * 33 + n;
        v4u o; o.x = pk2(s[0 * 33], s[1 * 33]); o.y = pk2(s[2 * 33], s[3 * 33]); o.z = pk2(s[4 * 33], s[5 * 33]); o.w = pk2(s[6 * 33], s[7 * 33]);
        *(GAS v4u*)(WT + (size_t)rm(n0 + n) * K + k0 + 8 * c) = o; }
    LDS_WAIT(); asm volatile("" ::: "memory");
}
__device__ __forceinline__ void p0_prologue(Frame& F) {
    LAS float* scr = (LAS float*)(F.lds + F.wave * 16384);
    const int gw = F.vcu * NWAVES + F.wave, NGW = F.G * NWAVES;
    constexpr int I_IN = 16 * 112, I_O = 16 * 32, I_G = 16 * 256, I_U = 16 * 256, I_D = 16 * 256;
    constexpr int NITEMS = I_IN + I_O + I_G + I_U + I_D;
    for (int it = gw; it < NITEMS; it += NGW) {
        int r = it;
        if (r < I_IN) { p0_transpose_item(F_w_in, D, INW, F_WIN_T, scr, r, F.lane, [](int n) { return n; }); continue; } r -= I_IN;
        if (r < I_O) { p0_transpose_item(F_w_o, D, D, F_WO_T, scr, r, F.lane, [](int n) { return n; }); continue; } r -= I_O;
        if (r < I_G) { const int e = r >> 8; p0_transpose_item(F_w_gate + (size_t)e * D * DE, D, DE, F_WGU_T + (size_t)e * 1024 * 1024, scr, r & 255, F.lane, [](int n) { return 256 * (n >> 7) + (n & 127); }); continue; } r -= I_G;
        if (r < I_U) { const int e = r >> 8; p0_transpose_item(F_w_up + (size_t)e * D * DE, D, DE, F_WGU_T + (size_t)e * 1024 * 1024, scr, r & 255, F.lane, [](int n) { return 256 * (n >> 7) + 128 + (n & 127); }); continue; } r -= I_U;
        { const int e = r >> 8; p0_transpose_item(F_w_down + (size_t)e * DE * D, DE, D, F_WD_T + (size_t)e * 1024 * 512, scr, r & 255, F.lane, [](int n) { return n; }); }
    }
    for (int m = gw; m < T; m += NGW) {
        const GAS f32x4* xr = (const GAS f32x4*)(F_x + (size_t)m * D) + F.lane;
        GAS v2u* o8 = (GAS v2u*)(F_XB + (size_t)m * D) + F.lane;
#pragma unroll
        for (int j = 0; j < 4; ++j) { const f32x4 v = xr[64 * j]; v2u o; o.x = pk2(v.x, v.y); o.y = pk2(v.z, v.w); o8[64 * j] = o; }
    }
    const int gt = blockIdx.x * NT + F.tid, NGT = F.G * NT;
    for (int i = gt; i < 1024 * 20; i += NGT) { const int c = i / 20, k = i % 20;
        F_WR[i] = (k < 4) ? F_w_grp[c * 4 + k] : F_w_exp[((size_t)((k - 4) >> 2) * 1024 + c) * 4 + ((k - 4) & 3)]; }
    for (int i = gt; i < 512; i += NGT) { const float l0 = F_lbl[i], l1 = F_lbl[512 + i]; F_LB[i] = 1.f / (1.f + __expf(l1 - l0)); }
    for (int i = gt; i < 8 * 128; i += NGT) { const int h = i >> 7, n = i & 127; int bk;
        if (n < 16) bk = n; else { bk = 16 + (int)(logf((float)n / 16.f) / logf(8.f) * 16.f); bk = bk > 31 ? 31 : bk; }
        F_BIASN[i] = F_t5[bk * 8 + h]; }
}

namespace pg8 {
typedef short bf16x8 __attribute__((ext_vector_type(8)));
typedef unsigned u32x4 __attribute__((ext_vector_type(4)));
constexpr int BM = 256, BK = 64, HALF = 128, HTB = HALF * BK * 2, STAGE_BYTES = 8 * HTB, NXCD = 8, WGM = 8;
__device__ __forceinline__ int lds_byte(int r, int c) { const int st = (r >> 4) * 2 + (c >> 5), rr = r & 15, cc = c & 31, ob = rr * 64 + cc * 2; return st * 1024 + (ob ^ (((ob >> 9) & 1) << 5)); }
__device__ __forceinline__ void stage_rc(int b, int& R, int& C) { const int st = b / 1024, sb = b % 1024, swz = sb ^ (((sb >> 9) & 1) << 5); R = (st >> 1) * 16 + swz / 64; C = (st & 1) * 32 + (swz % 64) / 2; }
__device__ __forceinline__ int perm32(int rho) { const int n = rho >> 4, i = rho & 15; return 8 * (i >> 2) + 4 * n + (i & 3); }
struct Unit { int pm, pn, e, rows; };
__device__ __forceinline__ unsigned cvt_pk_bf16(float lo, float hi) { unsigned r; asm volatile("v_cvt_pk_bf16_f32 %0, %1, %2" : "=v"(r) : "v"(lo), "v"(hi)); return r; }

struct StaticOrder {
    int nM, nN, nwg, G, c, K; const char* Bt;
    __device__ void init(int M, int N, int K_, int G_, int c_, const void* Bt_) { nM = M / BM; nN = N / BM; nwg = nM * nN; G = G_; c = c_; K = K_; Bt = (const char*)Bt_; }
    __device__ __forceinline__ bool next(int i, Unit& u) const {
        const long L = (long)i * G + c; if (L >= nwg) return false;
        int wgid = (int)L; { const int q = nwg / NXCD, r = nwg % NXCD, xcd = wgid % NXCD, off = wgid / NXCD; wgid = (xcd < r ? xcd * (q + 1) : r * (q + 1) + (xcd - r) * q) + off; }
        const int nig = WGM * nN, gid = wgid / nig, fm = gid * WGM, gsz = (nM - fm) < WGM ? (nM - fm) : WGM;
        u.pm = fm + ((wgid % nig) % gsz); u.pn = (wgid % nig) / gsz; u.e = 0; u.rows = 256; return true;
    }
    __device__ __forceinline__ int arow(const Unit& u, int r) const { return u.pm * BM + r; }
    __device__ __forceinline__ const char* bptr(const Unit& u) const { return Bt + (size_t)u.pn * BM * K * 2; }
};

template <class Epi, class Sched, bool ALIGN_EPI>
__device__ __forceinline__ void gemm_phase(LAS unsigned char* lds, const bf16* Aptr, const int K, const Sched& S, const Epi& E) {
    const int tid = threadIdx.x, wid = __builtin_amdgcn_readfirstlane(tid >> 6), lane = tid & 63, wr = wid >> 2, wc = wid & 3, fr = lane & 15, fq = lane >> 4;
    const int nt = K / BK;
    int RA[2]; unsigned CA2[2], voffB[2];
#pragma unroll
    for (int i = 0; i < 2; ++i) { int R, C; stage_rc(tid * 16 + i * 8192, R, C); const int Rb = Epi::PERM ? ((R & ~31) + perm32(R & 31)) : R;
        RA[i] = R; CA2[i] = (unsigned)C * 2u; voffB[i] = (unsigned)(Rb * K + C) * 2u; }
    const size_t kstep = (size_t)(BK * 2);
    const size_t hstep = (size_t)HALF * K * 2;
    const unsigned ldsw = (unsigned)wid * 1024u;
    const int aoff = lds_byte(wr * 64 + fr, fq * 8), boff = lds_byte(wc * 32 + fr, fq * 8);
    const char* Ab = (const char*)Aptr;
    const unsigned rowb = (unsigned)K * 2u;
#define PG8_SA(b, h) (((b) * 2 + (h)) * HTB)
#define PG8_SB(b, h) ((4 + (b) * 2 + (h)) * HTB)
#define PG8_STAGE_B(bufoff, gbase) do { _Pragma("unroll") for (int _i = 0; _i < 2; ++_i) \
        __builtin_amdgcn_global_load_lds((const unsigned*)((const char*)(gbase) + voffB[_i]), (LAS unsigned*)(lds + (bufoff) + ldsw + _i * 8192), 16, 0, 0); } while (0)
#define PG8_STAGE_A(bufoff, kb, o0, o1) do { \
        __builtin_amdgcn_global_load_lds((const unsigned*)(Ab + (kb) + (o0)), (LAS unsigned*)(lds + (bufoff) + ldsw), 16, 0, 0); \
        __builtin_amdgcn_global_load_lds((const unsigned*)(Ab + (kb) + (o1)), (LAS unsigned*)(lds + (bufoff) + ldsw + 8192), 16, 0, 0); } while (0)
#define PG8_LDA(dst, b, h) do { _Pragma("unroll") for (int m = 0; m < 4; ++m) _Pragma("unroll") for (int k = 0; k < 2; ++k) dst[m][k] = *(const LAS bf16x8*)(lds + PG8_SA(b, h) + aoff + m * 2048 + k * 1024); } while (0)
#define PG8_LDB(dst, b, h) do { _Pragma("unroll") for (int n = 0; n < 2; ++n) _Pragma("unroll") for (int k = 0; k < 2; ++k) dst[n][k] = *(const LAS bf16x8*)(lds + PG8_SB(b, h) + boff + n * 2048 + k * 1024); } while (0)
#define PG8_MMA(ai, bj, At, Bt) do { __builtin_amdgcn_s_setprio(1); _Pragma("unroll") for (int m = 0; m < 4; ++m) _Pragma("unroll") for (int n = 0; n < 2; ++n) _Pragma("unroll") for (int k = 0; k < 2; ++k) \
        acc[ai][bj][m][n] = __builtin_amdgcn_mfma_f32_16x16x32_bf16(Bt[n][k], At[m][k], acc[ai][bj][m][n], 0, 0, 0); __builtin_amdgcn_s_setprio(0); } while (0)
#define PG8_WAIT_V(n) asm volatile("s_waitcnt vmcnt(" #n ")" ::: "memory")
#define PG8_WAIT_L(n) asm volatile("s_waitcnt lgkmcnt(" #n ")" ::: "memory")
#define PG8_BAR __builtin_amdgcn_s_barrier()
#define PG8_SCHED __builtin_amdgcn_sched_barrier(0)
#define PG8_OFFS(dst, u) do { _Pragma("unroll") for (int _h = 0; _h < 2; ++_h) _Pragma("unroll") for (int _i = 0; _i < 2; ++_i) dst[_h][_i] = (unsigned)S.arow(u, _h * HALF + RA[_i]) * rowb + CA2[_i]; } while (0)
    Unit cur, nxt; int ui = 0;
    if (!S.next(0, cur)) return;
    f32x4 acc[2][2][4][2];
#pragma unroll
    for (int a = 0; a < 2; ++a)
#pragma unroll
        for (int b = 0; b < 2; ++b)
#pragma unroll
            for (int m = 0; m < 4; ++m)
#pragma unroll
                for (int n = 0; n < 2; ++n) acc[a][b][m][n] = (f32x4){0.f, 0.f, 0.f, 0.f};
    bf16x8 At[4][2], B0[2][2], B1[2][2];
    unsigned offC[2][2], offN[2][2];
    PG8_OFFS(offC, cur);
    const char* cB = S.bptr(cur);
    PG8_STAGE_B(PG8_SB(0, 0), cB); PG8_STAGE_B(PG8_SB(0, 1), cB + hstep); PG8_STAGE_A(PG8_SA(0, 0), 0, offC[0][0], offC[0][1]); PG8_STAGE_A(PG8_SA(0, 1), 0, offC[1][0], offC[1][1]);
    if (wr == 1) PG8_BAR;
    PG8_WAIT_V(2); PG8_BAR;
    PG8_STAGE_B(PG8_SB(1, 0), cB + kstep); PG8_STAGE_A(PG8_SA(1, 0), kstep, offC[0][0], offC[0][1]); PG8_STAGE_B(PG8_SB(1, 1), cB + hstep + kstep);
    PG8_WAIT_V(6); PG8_BAR;
    for (;;) {
        const bool has_next = S.next(ui + 1, nxt);
        const char* nB = cB;
        if (has_next) { PG8_OFFS(offN, nxt); nB = S.bptr(nxt); }
        else {
#pragma unroll
            for (int _h = 0; _h < 2; ++_h)
#pragma unroll
                for (int _i = 0; _i < 2; ++_i) offN[_h][_i] = offC[_h][_i]; }
        for (int t = 0; t < nt; t += 2) {
            const bool last = (t == nt - 2);
            const size_t k1 = (size_t)(t + 1) * kstep;
            const size_t k2 = last ? 0 : (size_t)(t + 2) * kstep, k3 = k2 + kstep;
            const char* b2 = last ? nB : cB + (size_t)(t + 2) * kstep; const char* b3 = b2 + kstep;
            const unsigned o00 = last ? offN[0][0] : offC[0][0], o01 = last ? offN[0][1] : offC[0][1], o10 = last ? offN[1][0] : offC[1][0], o11 = last ? offN[1][1] : offC[1][1];
            PG8_LDB(B0, 0, 0); PG8_LDB(B1, 0, 1); PG8_SCHED; PG8_LDA(At, 0, 0); PG8_STAGE_A(PG8_SA(1, 1), k1, offC[1][0], offC[1][1]);
            PG8_WAIT_V(8); PG8_WAIT_L(0); PG8_BAR; PG8_MMA(0, 0, At, B0); PG8_MMA(0, 1, At, B1); PG8_BAR; PG8_SCHED;
            PG8_LDA(At, 0, 1); PG8_STAGE_B(PG8_SB(0, 0), b2); PG8_STAGE_B(PG8_SB(0, 1), b2 + hstep); PG8_STAGE_A(PG8_SA(0, 0), k2, o00, o01);
            PG8_WAIT_V(8); PG8_WAIT_L(0); PG8_BAR; PG8_MMA(1, 0, At, B0); PG8_MMA(1, 1, At, B1); PG8_BAR; PG8_SCHED;
            PG8_LDB(B0, 1, 0); PG8_LDB(B1, 1, 1); PG8_SCHED; PG8_LDA(At, 1, 0); PG8_STAGE_A(PG8_SA(0, 1), k2, o10, o11);
            PG8_WAIT_V(8); PG8_WAIT_L(0); PG8_BAR; PG8_MMA(0, 0, At, B0); PG8_MMA(0, 1, At, B1); PG8_BAR; PG8_SCHED;
            PG8_LDA(At, 1, 1); PG8_STAGE_B(PG8_SB(1, 0), b3); PG8_STAGE_B(PG8_SB(1, 1), b3 + hstep); PG8_STAGE_A(PG8_SA(1, 0), k3, o00, o01);
            PG8_WAIT_V(8); PG8_WAIT_L(0); PG8_BAR; PG8_MMA(1, 0, At, B0); PG8_MMA(1, 1, At, B1); PG8_BAR; PG8_SCHED;
        }
        if constexpr (ALIGN_EPI) { if (wr == 0) PG8_BAR; }
        E(acc, cur, wr, wc, fr, fq);
        if (!has_next) break;
#pragma unroll
        for (int a = 0; a < 2; ++a)
#pragma unroll
            for (int b = 0; b < 2; ++b)
#pragma unroll
                for (int m = 0; m < 4; ++m)
#pragma unroll
                    for (int n = 0; n < 2; ++n) acc[a][b][m][n] = (f32x4){0.f, 0.f, 0.f, 0.f};
        cur = nxt; cB = nB; ++ui;
#pragma unroll
        for (int _h = 0; _h < 2; ++_h)
#pragma unroll
            for (int _i = 0; _i < 2; ++_i) offC[_h][_i] = offN[_h][_i];
        if constexpr (ALIGN_EPI) { if (wr == 1) PG8_BAR; }
    }
    PG8_WAIT_V(0);
    if constexpr (!ALIGN_EPI) { if (wr == 0) PG8_BAR; }
    PG8_BAR;
#undef PG8_SA
#undef PG8_SB
#undef PG8_STAGE_A
#undef PG8_STAGE_B
#undef PG8_LDA
#undef PG8_LDB
#undef PG8_MMA
#undef PG8_WAIT_V
#undef PG8_WAIT_L
#undef PG8_BAR
#undef PG8_SCHED
#undef PG8_OFFS
}

struct EpiInProj {
    static constexpr bool PERM = true;
    unsigned char* ws; float* kmean;
    __device__ __forceinline__ void operator()(const f32x4 (&acc)[2][2][4][2], const Unit& u, int wr, int wc, int fr, int fq) const {
        const int grp = u.pn >> 1, colt = (u.pn & 1) * 256, row0 = u.pm * BM + wr * 64 + fr, col0 = colt + wc * 32 + 8 * fq;
        if (grp != 2) {
            bf16* base = (bf16*)(ws + WS_PROJ + (size_t)grp * PROJ_SLOT);
#pragma unroll
            for (int ai = 0; ai < 2; ++ai)
#pragma unroll
                for (int m = 0; m < 4; ++m) { bf16* rowp = base + (size_t)(row0 + ai * HALF + m * 16) * AW + col0;
#pragma unroll
                    for (int bj = 0; bj < 2; ++bj) { const f32x4 v0 = acc[ai][bj][m][0], v1 = acc[ai][bj][m][1];
                        u32x4 w; w.x = cvt_pk_bf16(v0[0], v0[1]); w.y = cvt_pk_bf16(v0[2], v0[3]); w.z = cvt_pk_bf16(v1[0], v1[1]); w.w = cvt_pk_bf16(v1[2], v1[3]);
                        *(u32x4*)(rowp + bj * HALF) = w; } }
            if (grp == 1) {
                const int b = u.pm >> 5, jb = u.pm & 31;
#pragma unroll
                for (int bj = 0; bj < 2; ++bj)
#pragma unroll
                    for (int n = 0; n < 2; ++n)
#pragma unroll
                        for (int j = 0; j < 4; ++j) { float s = 0.f;
#pragma unroll
                            for (int ai = 0; ai < 2; ++ai)
#pragma unroll
                                for (int m = 0; m < 4; ++m) s += acc[ai][bj][m][n][j];
                            s += __shfl_xor(s, 1); s += __shfl_xor(s, 2); s += __shfl_xor(s, 4); s += __shfl_xor(s, 8);
                            if (fr == 0) { const int cc = col0 + bj * HALF + 4 * n + j; atomicAdd(kmean + ((size_t)((b * 8 + (cc >> 6)) * 32 + jb)) * 64 + (cc & 63), s); } }
            }
        } else {
            bf16* vt = (bf16*)(ws + WS_PROJ + 2 * PROJ_SLOT); const int b = u.pm >> 5; const bool odd = fr & 1;
#pragma unroll
            for (int ai = 0; ai < 2; ++ai)
#pragma unroll
                for (int m = 0; m < 4; ++m) { const int t = ((row0 + ai * HALF + m * 16) & (SEQ - 1)) - (odd ? 1 : 0);
#pragma unroll
                    for (int bj = 0; bj < 2; ++bj)
#pragma unroll
                        for (int p = 0; p < 4; ++p) { const float a = acc[ai][bj][m][p >> 1][(2 * p) & 3], bb = acc[ai][bj][m][p >> 1][(2 * p + 1) & 3];
                            const float recv = __shfl_xor(odd ? a : bb, 1);
                            const int col = col0 + bj * HALF + 2 * p + (odd ? 1 : 0);
                            *(unsigned*)(vt + ((size_t)((b * 8 + (col >> 6)) * 64 + (col & 63))) * SEQ + t) = odd ? cvt_pk_bf16(recv, bb) : cvt_pk_bf16(a, recv); } }
        }
    }
};
struct EpiOutProj {
    static constexpr bool PERM = false;
    const float* x; float* y;
    __device__ __forceinline__ void operator()(const f32x4 (&acc)[2][2][4][2], const Unit& u, int wr, int wc, int fr, int fq) const {
        const int col0 = u.pn * BM + wc * 32 + 4 * fq;
#pragma unroll
        for (int ai = 0; ai < 2; ++ai)
#pragma unroll
            for (int m = 0; m < 4; ++m) { const size_t off = (size_t)(u.pm * BM + ai * HALF + wr * 64 + m * 16 + fr) * D + col0;
#pragma unroll
                for (int bj = 0; bj < 2; ++bj)
#pragma unroll
                    for (int n = 0; n < 2; ++n) { const f32x4 xv = *(const f32x4*)(x + off + bj * HALF + n * 16); *(f32x4*)(y + off + bj * HALF + n * 16) = xv * ALPHA + acc[ai][bj][m][n]; } }
    }
};
struct EpiMoe1 {
    static constexpr bool PERM = true;
    bf16* H;
    __device__ __forceinline__ void operator()(const f32x4 (&acc)[2][2][4][2], const Unit& u, int wr, int wc, int fr, int fq) const {
#pragma unroll
        for (int ai = 0; ai < 2; ++ai)
#pragma unroll
            for (int m = 0; m < 4; ++m) { const int rl = ai * HALF + wr * 64 + m * 16 + fr;
                if (rl < u.rows) { u32x4 w; float h[8];
#pragma unroll
                    for (int n = 0; n < 2; ++n)
#pragma unroll
                        for (int j = 0; j < 4; ++j) { const float g = acc[ai][0][m][n][j], up = acc[ai][1][m][n][j]; h[4 * n + j] = g * up / (1.f + __expf(-g)); }
                    w.x = cvt_pk_bf16(h[0], h[1]); w.y = cvt_pk_bf16(h[2], h[3]); w.z = cvt_pk_bf16(h[4], h[5]); w.w = cvt_pk_bf16(h[6], h[7]);
                    *(u32x4*)(H + (size_t)(u.pm * BM + rl) * DE + u.pn * 128 + wc * 32 + 8 * fq) = w; } }
    }
};
struct EpiMoe2 {
    static constexpr bool PERM = true;
    bf16* YE; const float* EW; const LAS int* tbl;
    __device__ __forceinline__ void operator()(const f32x4 (&acc)[2][2][4][2], const Unit& u, int wr, int wc, int fr, int fq) const {
        const int pos0 = (u.pm - tbl[u.e]) * BM;
#pragma unroll
        for (int ai = 0; ai < 2; ++ai)
#pragma unroll
            for (int m = 0; m < 4; ++m) { const int rl = ai * HALF + wr * 64 + m * 16 + fr;
                if (rl < u.rows) { const float wt = EW[(size_t)u.e * T + pos0 + rl];
#pragma unroll
                    for (int bj = 0; bj < 2; ++bj) { const f32x4 v0 = acc[ai][bj][m][0] * wt, v1 = acc[ai][bj][m][1] * wt;
                        u32x4 w; w.x = cvt_pk_bf16(v0[0], v0[1]); w.y = cvt_pk_bf16(v0[2], v0[3]); w.z = cvt_pk_bf16(v1[0], v1[1]); w.w = cvt_pk_bf16(v1[2], v1[3]);
                        *(u32x4*)(YE + (size_t)(u.pm * BM + rl) * D + u.pn * BM + bj * HALF + wc * 32 + 8 * fq) = w; } } }
    }
};
struct MoeOrder {
    const LAS int* tbl; int G, c, K; const int* elist; const char* W; size_t estride; bool gather;
    __device__ __forceinline__ bool next(int i, Unit& u) const {
        const int L = i * G + c, MT = __builtin_amdgcn_readfirstlane(tbl[16]); if (L >= MT * 4) return false;
        const int mt = L >> 2; int e = 0;
#pragma unroll
        for (int k = 1; k < 16; ++k) e = (__builtin_amdgcn_readfirstlane(tbl[k]) <= mt) ? k : e;
        const int rem = __builtin_amdgcn_readfirstlane(tbl[32 + e]) - (mt - __builtin_amdgcn_readfirstlane(tbl[e])) * BM;
        u.pm = mt; u.pn = L & 3; u.e = e; u.rows = rem < BM ? rem : BM; return true;
    }
    __device__ __forceinline__ int arow(const Unit& u, int r) const {
        if (!gather) return u.pm * BM + r;
        const int pos0 = (u.pm - tbl[u.e]) * BM; const int rr = r < u.rows ? r : u.rows - 1;
        return elist[(size_t)u.e * T + pos0 + rr];
    }
    __device__ __forceinline__ const char* bptr(const Unit& u) const { return W + (size_t)u.e * estride + (size_t)u.pn * BM * K * 2; }
};
}

namespace attn {
typedef short bf16x8 __attribute__((ext_vector_type(8)));
typedef float f32x16 __attribute__((ext_vector_type(16)));
constexpr float LOG2E = 1.4426950408889634f, C1 = 0.125f * LOG2E;
constexpr int KS_STRIDE = 144, VS_STRIDE = 520;
constexpr int L_KS = 0, L_VS = 36864, L_BL = L_VS + 33280, L_SCH = L_BL + 1024;
__device__ __forceinline__ int crow(int r, int hi) { return (r & 3) + 8 * (r >> 2) + 4 * hi; }
__device__ __forceinline__ unsigned cvtpk(float lo, float hi) { unsigned r; asm volatile("v_cvt_pk_bf16_f32 %0, %1, %2" : "=v"(r) : "v"(lo), "v"(hi)); return r; }

__device__ __forceinline__ void x1_select(Frame& F) {
    LAS float* km = (LAS float*)F.lds;
    LAS int* lc = (LAS int*)(F.lds + 8192);
    LAS int* gb = lc + 32;
    unsigned short* LIST = (unsigned short*)(F_ws + WS_LIST);
    for (int item = F.vcu; item < 16 * 31; item += F.G) {
        const int bh = item / 31, n = 1 + item % 31, b = bh >> 3, hd = bh & 7;
        for (int i = F.tid; i < n * 64; i += NT) km[i] = F_KMEAN[(size_t)bh * 2048 + i];
        if (F.tid < 32) lc[F.tid] = 0;
        __syncthreads();
        int s0 = -1, s1 = -1, s2 = -1, p0 = 0, p1 = 0, p2 = 0;
        if (F.tid < 256) {
            float q[64];
            { const GAS v4u* qp = (const GAS v4u*)(F_QB + ((size_t)(b * SEQ + n * 256 + F.tid)) * AW + hd * 64);
#pragma unroll
              for (int c = 0; c < 8; ++c) { const v4u w = qp[c];
                  q[8*c+0] = bf2f(w.x & 0xffff); q[8*c+1] = bf2f(w.x >> 16); q[8*c+2] = bf2f(w.y & 0xffff); q[8*c+3] = bf2f(w.y >> 16);
                  q[8*c+4] = bf2f(w.z & 0xffff); q[8*c+5] = bf2f(w.z >> 16); q[8*c+6] = bf2f(w.w & 0xffff); q[8*c+7] = bf2f(w.w >> 16); } }
            float g0 = -INFINITY, g1 = -INFINITY, g2 = -INFINITY;
            for (int j = 0; j < n; ++j) { float g = 0.f; const LAS f32x4* kp = (const LAS f32x4*)(km + j * 64);
#pragma unroll
                for (int c = 0; c < 16; ++c) { const f32x4 kv = kp[c]; g += q[4*c] * kv.x + q[4*c+1] * kv.y + q[4*c+2] * kv.z + q[4*c+3] * kv.w; }
                if (g > g0) { g2 = g1; s2 = s1; g1 = g0; s1 = s0; g0 = g; s0 = j; }
                else if (g > g1) { g2 = g1; s2 = s1; g1 = g; s1 = j; }
                else if (g > g2) { g2 = g; s2 = j; } }
            if (s0 >= 0) p0 = atomicAdd((int*)&lc[s0], 1);
            if (s1 >= 0) p1 = atomicAdd((int*)&lc[s1], 1);
            if (s2 >= 0) p2 = atomicAdd((int*)&lc[s2], 1);
        }
        __syncthreads();
        if (F.tid < n) gb[F.tid] = (int)__hip_atomic_fetch_add(F.ctl + CW_LCNT + bh * 32 + F.tid, (unsigned)lc[F.tid], RLX_AGENT);
        __syncthreads();
        if (F.tid < 256) { const unsigned qv = (unsigned)(n * 256 + F.tid);
            if (s0 >= 0) LIST[(size_t)(bh * 32 + s0) * 8192 + gb[s0] + p0] = (unsigned short)(qv);
            if (s1 >= 0) LIST[(size_t)(bh * 32 + s1) * 8192 + gb[s1] + p1] = (unsigned short)(qv | (1u << 13));
            if (s2 >= 0) LIST[(size_t)(bh * 32 + s2) * 8192 + gb[s2] + p2] = (unsigned short)(qv | (2u << 13)); }
        __syncthreads();
    }
}
__device__ __forceinline__ void stage_kv(Frame& F, int bh, int j) {
    const int b = bh >> 3, hd = bh & 7;
#pragma unroll
    for (int i = 0; i < 4; ++i) { const int idx = F.tid + NT * i, r = idx >> 3, c = idx & 7;
        const v4u v = *(const GAS v4u*)(F_KB + ((size_t)(b * SEQ + j * 256 + r)) * AW + hd * 64 + c * 8);
        *(LAS v4u*)(F.lds + L_KS + r * KS_STRIDE + c * 16) = v; }
#pragma unroll
    for (int i = 0; i < 4; ++i) { const int idx = F.tid + NT * i, d = idx >> 5, c = idx & 31;
        const v4u v = *(const GAS v4u*)(F_VT + ((size_t)(bh * 64 + d)) * SEQ + j * 256 + c * 8);
        LAS v2u* p = (LAS v2u*)(F.lds + L_VS + d * VS_STRIDE + c * 16); p[0] = (v2u){v.x, v.y}; p[1] = (v2u){v.z, v.w}; }
    if (F.tid < 129) ((LAS float*)(F.lds + L_BL))[F.tid] = F.tid == 0 ? -INFINITY : F_BIASN[hd * 128 + F.tid - 1] * LOG2E;
}
template <int MODE>
__device__ __forceinline__ void attn_core(LAS unsigned char* lds, const bf16x8 (&qf)[4], int qt, int kbase, int ntile, float& m_out, float& l_out, f32x16 (&o)[2], int lane) {
    const int r32 = lane & 31, hi = lane >> 5;
    f32x16 acc[8];
#pragma unroll
    for (int kt = 0; kt < 8; ++kt) {
        acc[kt] = (f32x16){};
#pragma unroll
        for (int s = 0; s < 4; ++s) { const bf16x8 a = *(const LAS bf16x8*)(lds + L_KS + (32 * kt + r32) * KS_STRIDE + 32 * s + 16 * hi);
            acc[kt] = __builtin_amdgcn_mfma_f32_32x32x16_bf16(a, qf[s], acc[kt], 0, 0, 0); }
        __builtin_amdgcn_sched_barrier(0); }
    const LAS float* BL = (const LAS float*)(lds + L_BL);
    int opq = 1; asm volatile("" : "+s"(opq));
    const bool near = (MODE == 1) ? (opq != 0) : (__any((qt >> 8) - 1 == (kbase >> 8)) != 0);
    const float b31 = BL[128];
    float mx = -INFINITY;
#pragma unroll
    for (int kt = 0; kt < 8; ++kt) {
        if (near) {
#pragma unroll
            for (int r = 0; r < 16; ++r) { const int dist = qt - (kbase + 32 * kt + crow(r, hi)); const int di = min(max(dist, -1), 127) + 1;
                const float t = acc[kt][r] * C1 + BL[di]; acc[kt][r] = t; mx = fmaxf(mx, t); }
        } else {
#pragma unroll
            for (int r = 0; r < 16; ++r) { const float t = acc[kt][r] * C1 + b31; acc[kt][r] = t; mx = fmaxf(mx, t); }
        }
        __builtin_amdgcn_sched_barrier(0); }
    mx = fmaxf(mx, __shfl_xor(mx, 32));
    float ls = 0.f;
#pragma unroll
    for (int kt = 0; kt < 8; ++kt) {
#pragma unroll
        for (int r = 0; r < 16; ++r) { const float p = __builtin_amdgcn_exp2f(acc[kt][r] - mx); acc[kt][r] = p; ls += p; } }
    ls += __shfl_xor(ls, 32);
    o[0] = (f32x16){}; o[1] = (f32x16){};
#pragma unroll
    for (int kt = 0; kt < 8; ++kt) {
#pragma unroll
        for (int s2 = 0; s2 < 2; ++s2) {
            v4u pw; pw.x = cvtpk(acc[kt][8*s2+0], acc[kt][8*s2+1]); pw.y = cvtpk(acc[kt][8*s2+2], acc[kt][8*s2+3]); pw.z = cvtpk(acc[kt][8*s2+4], acc[kt][8*s2+5]); pw.w = cvtpk(acc[kt][8*s2+6], acc[kt][8*s2+7]);
            const bf16x8 pf = __builtin_bit_cast(bf16x8, pw);
#pragma unroll
            for (int dt = 0; dt < 2; ++dt) { const LAS unsigned char* vp = lds + L_VS + (32 * dt + r32) * VS_STRIDE + 64 * kt + 32 * s2 + 8 * hi;
                const v2u lo = *(const LAS v2u*)vp, hv = *(const LAS v2u*)(vp + 16);
                const bf16x8 vf = __builtin_bit_cast(bf16x8, (v4u){lo.x, lo.y, hv.x, hv.y});
                o[dt] = __builtin_amdgcn_mfma_f32_32x32x16_bf16(vf, pf, o[dt], 0, 0, 0); } }
        __builtin_amdgcn_sched_barrier(0); }
    m_out = mx; l_out = ls;
}
__device__ __forceinline__ void load_q(Frame& F, bf16x8 (&qf)[4], int b, int hd, int qt, int hi) {
    const GAS v4u* qp = (const GAS v4u*)(F_QB + ((size_t)(b * SEQ + qt)) * AW + hd * 64 + 8 * hi);
#pragma unroll
    for (int s = 0; s < 4; ++s) qf[s] = __builtin_bit_cast(bf16x8, qp[2 * s]);
}
__device__ __forceinline__ void x2_partials(Frame& F) {
    LAS int* pre = (LAS int*)(F.lds + L_SCH);
    const unsigned short* LIST = (const unsigned short*)(F_ws + WS_LIST);
    bf16* POUT = (bf16*)F_out; float* ML = (float*)(F_ws + WS_ML);
    { const int c = (int)F.ctl[CW_LCNT + F.tid]; pre[1 + F.tid] = (((c + 31) >> 5) + 15) >> 4; }
    if (F.tid == 0) pre[0] = 0;
    __syncthreads();
    if (F.tid == 0) { int a = 0; for (int i = 1; i <= 512; ++i) { a += pre[i]; pre[i] = a; } }
    __syncthreads();
    const int NS = pre[512];
    const int r32 = F.lane & 31, hi = F.lane >> 5;
    for (int sidx = F.vcu; sidx < NS; sidx += F.G) {
        int lo = 0, hh = 512;
        while (hh - lo > 1) { const int mid = (lo + hh) >> 1; if (pre[mid] <= sidx) lo = mid; else hh = mid; }
        const int it = lo, bh = it >> 5, j = it & 31, b = bh >> 3, hd = bh & 7, sub = sidx - pre[it];
        const int Lj = (int)F.ctl[CW_LCNT + it], nch = (Lj + 31) >> 5;
        const int c0 = sub * 16, c1 = (c0 + 16 < nch) ? c0 + 16 : nch;
        stage_kv(F, bh, j);
        __syncthreads();
        for (int c = c0 + F.wave; c < c1; c += NWAVES) {
            const int idx = c * 32 + r32; const bool valid = idx < Lj;
            const unsigned e = LIST[(size_t)it * 8192 + (valid ? idx : Lj - 1)];
            const int qt = (int)(e & 8191u), slot = (int)(e >> 13);
            bf16x8 qf[4]; load_q(F, qf, b, hd, qt, hi);
            float m, l; f32x16 o[2];
            attn_core<0>(F.lds, qf, qt, j * 256, 8, m, l, o, F.lane);
            if (valid) { const size_t prow = ((size_t)slot * T + b * SEQ + qt) * 8 + hd;
                if (hi == 0) *(GAS f32x2*)(ML + prow * 2) = (f32x2){m, l};
#pragma unroll
                for (int dt = 0; dt < 2; ++dt)
#pragma unroll
                    for (int g = 0; g < 4; ++g) { v2u w; w.x = cvtpk(o[dt][4*g], o[dt][4*g+1]); w.y = cvtpk(o[dt][4*g+2], o[dt][4*g+3]);
                        *(GAS v2u*)(POUT + prow * 64 + 32 * dt + 8 * g + 4 * hi) = w; } }
        }
        __syncthreads();
    }
}
__device__ __forceinline__ void x3_own_merge(Frame& F) {
    const bf16* POUT = (const bf16*)F_out; const float* ML = (const float*)(F_ws + WS_ML);
    const int r32 = F.lane & 31, hi = F.lane >> 5;
    for (int item = F.vcu; item < 16 * 32; item += F.G) {
        const int bh = item >> 5, n = item & 31, b = bh >> 3, hd = bh & 7;
        stage_kv(F, bh, n);
        __syncthreads();
        int qt = n * 256 + 32 * F.wave + r32; asm volatile("" : "+v"(qt));
        bf16x8 qf[4]; load_q(F, qf, b, hd, qt, hi);
        float M, L; f32x16 o[2];
        attn_core<1>(F.lds, qf, qt, n * 256, F.wave + 1, M, L, o, F.lane);
        const int nsel = n < 3 ? n : 3;
        for (int s = 0; s < nsel; ++s) {
            const size_t prow = ((size_t)s * T + b * SEQ + qt) * 8 + hd;
            const f32x2 ml = *(const GAS f32x2*)(ML + prow * 2);
            const float Mn = fmaxf(M, ml.x), a = __builtin_amdgcn_exp2f(M - Mn), bs = __builtin_amdgcn_exp2f(ml.x - Mn);
            L = L * a + ml.y * bs; M = Mn;
#pragma unroll
            for (int dt = 0; dt < 2; ++dt)
#pragma unroll
                for (int g = 0; g < 4; ++g) { const v2u w = *(const GAS v2u*)(POUT + prow * 64 + 32 * dt + 8 * g + 4 * hi);
                    o[dt][4*g]   = o[dt][4*g]   * a + bf2f(w.x & 0xffff) * bs; o[dt][4*g+1] = o[dt][4*g+1] * a + bf2f(w.x >> 16) * bs;
                    o[dt][4*g+2] = o[dt][4*g+2] * a + bf2f(w.y & 0xffff) * bs; o[dt][4*g+3] = o[dt][4*g+3] * a + bf2f(w.y >> 16) * bs; }
        }
        const float inv = 1.f / L;
        bf16* arow = F_AR + ((size_t)(b * SEQ + qt)) * D + hd * 64;
#pragma unroll
        for (int dt = 0; dt < 2; ++dt)
#pragma unroll
            for (int g = 0; g < 4; ++g) { v2u w; w.x = cvtpk(o[dt][4*g] * inv, o[dt][4*g+1] * inv); w.y = cvtpk(o[dt][4*g+2] * inv, o[dt][4*g+3] * inv);
                *(GAS v2u*)(arow + 32 * dt + 8 * g + 4 * hi) = w; }
        __syncthreads();
    }
}
}

namespace hgrn {
typedef short bf16x8 __attribute__((ext_vector_type(8)));
typedef float f32x16 __attribute__((ext_vector_type(16)));
constexpr int STR = 144;
constexpr int L_TOT = 0, L_QT = 2048, L_KT = L_QT + 9216, L_KP = L_KT + 9216, L_VT = L_KP + 9216, L_ST = L_VT + 9216, L_AT = L_ST + 9216;
__device__ __forceinline__ int crow(int r, int hi) { return (r & 3) + 8 * (r >> 2) + 4 * hi; }
__device__ __forceinline__ void gates(Frame& F, int row0, int h, float (&f)[8], float (&p)[8]) {
    const int k = F.tid & 63, sg = F.wave;
    const float lbk = F_LB[h * 64 + k];
    float run = 0.f; v4u vw; unsigned vv[8];
#pragma unroll
    for (int i = 0; i < 8; ++i) { const size_t off = (size_t)(row0 + 8 * sg + i) * AW + h * 64 + k;
        const float x = bf2f(F_HF[off]); vv[i] = F_HI[off];
        f[i] = lbk + (1.f - lbk) * sigmoidf_(x); run += __logf(f[i]); p[i] = run; }
    ((LAS float*)(F.lds + L_TOT))[sg * 64 + k] = run;
    vw.x = vv[0] | (vv[1] << 16); vw.y = vv[2] | (vv[3] << 16); vw.z = vv[4] | (vv[5] << 16); vw.w = vv[6] | (vv[7] << 16);
    *(LAS v4u*)(F.lds + L_VT + k * STR + sg * 16) = vw;
}
__device__ __forceinline__ void h1_local(Frame& F) {
    float* KVS = (float*)(F_ws + WS_XB); float* DEC = (float*)(F_ws + WS_DECAY);
    const int k = F.tid & 63, sg = F.wave, r32 = F.lane & 31, hi = F.lane >> 5;
    for (int ch = F.vcu; ch < 2048; ch += F.G) {
        const int bh = ch >> 7, c = ch & 127, b = bh >> 3, h = bh & 7, row0 = b * SEQ + c * 64;
        float f[8], p[8]; gates(F, row0, h, f, p);
        __syncthreads();
        const LAS float* tot = (const LAS float*)(F.lds + L_TOT);
        float off = 0.f, blast = 0.f;
#pragma unroll
        for (int s = 0; s < 8; ++s) { const float t = tot[s * 64 + k]; blast += t; off += (s < sg) ? t : 0.f; }
        { unsigned w[4];
#pragma unroll
          for (int i = 0; i < 4; ++i) w[i] = pk2((1.f - f[2*i]) * __expf(blast - (off + p[2*i])), (1.f - f[2*i+1]) * __expf(blast - (off + p[2*i+1])));
          *(LAS v4u*)(F.lds + L_KP + k * STR + sg * 16) = (v4u){w[0], w[1], w[2], w[3]}; }
        if (sg == 0) DEC[ch * 64 + k] = __expf(blast);
        __syncthreads();
        if (F.wave < 4) { const int kt = F.wave >> 1, vt = F.wave & 1; f32x16 acc = (f32x16){};
#pragma unroll
            for (int st = 0; st < 4; ++st) { const bf16x8 a = *(const LAS bf16x8*)(F.lds + L_KP + (32 * kt + r32) * STR + 32 * st + 16 * hi);
                const bf16x8 bb = *(const LAS bf16x8*)(F.lds + L_VT + (32 * vt + r32) * STR + 32 * st + 16 * hi);
                acc = __builtin_amdgcn_mfma_f32_32x32x16_bf16(a, bb, acc, 0, 0, 0); }
#pragma unroll
            for (int r = 0; r < 16; ++r) KVS[(size_t)ch * 4096 + (32 * kt + crow(r, hi)) * 64 + 32 * vt + r32] = acc[r]; }
        __syncthreads();
    }
}
__device__ __forceinline__ void h2_scan(Frame& F) {
    float* KVS = (float*)(F_ws + WS_XB); const float* DEC = (const float*)(F_ws + WS_DECAY);
    for (int e = blockIdx.x * NT + F.tid; e < 16 * 4096; e += F.G * NT) { const int bh = e >> 12, kv = e & 4095, k = kv >> 6;
        float st = 0.f;
        for (int c0 = 0; c0 < 128; c0 += 8) { float x[8], d[8];
#pragma unroll
            for (int u = 0; u < 8; ++u) { const int ch = bh * 128 + c0 + u; x[u] = KVS[(size_t)ch * 4096 + kv]; d[u] = DEC[ch * 64 + k]; }
#pragma unroll
            for (int u = 0; u < 8; ++u) { const int ch = bh * 128 + c0 + u; KVS[(size_t)ch * 4096 + kv] = st; st = d[u] * st + x[u]; } }
    }
}
__device__ __forceinline__ void h3_out(Frame& F) {
    const float* KVS = (const float*)(F_ws + WS_XB);
    const int k = F.tid & 63, sg = F.wave, r32 = F.lane & 31, hi = F.lane >> 5, l15 = F.lane & 15, kg = F.lane >> 4;
    for (int ch = F.vcu; ch < 2048; ch += F.G) {
        const int bh = ch >> 7, c = ch & 127, b = bh >> 3, h = bh & 7, row0 = b * SEQ + c * 64;
        float f[8], p[8]; gates(F, row0, h, f, p);
        float qq[8];
#pragma unroll
        for (int i = 0; i < 8; ++i) { const float x = bf2f(F_HQ[(size_t)(row0 + 8 * sg + i) * AW + h * 64 + k]); qq[i] = x * sigmoidf_(x); }
        float sv[8];
#pragma unroll
        for (int i = 0; i < 8; ++i) sv[i] = KVS[(size_t)ch * 4096 + (8 * sg + i) * 64 + k];
        __syncthreads();
        const LAS float* tot = (const LAS float*)(F.lds + L_TOT);
        float off = 0.f, bmid = 0.f;
#pragma unroll
        for (int s = 0; s < 8; ++s) { const float t = tot[s * 64 + k]; bmid += (s < 4) ? t : 0.f; off += (s < sg) ? t : 0.f; }
#pragma unroll
        for (int i = 0; i < 8; ++i) { const int t = 8 * sg + i; const float bt = off + p[i];
            *(LAS bf16*)(F.lds + L_QT + t * STR + k * 2) = (bf16)f2bf(qq[i] * __expf(bt - bmid));
            *(LAS bf16*)(F.lds + L_KT + t * STR + k * 2) = (bf16)f2bf((1.f - f[i]) * __expf(bmid - bt)); }
        { unsigned w[4];
#pragma unroll
          for (int i = 0; i < 4; ++i) { float e2[2];
#pragma unroll
              for (int u = 0; u < 2; ++u) { const int kk = 8 * sg + 2 * i + u; const float bm = (tot[kk] + tot[64 + kk]) + (tot[128 + kk] + tot[192 + kk]); e2[u] = sv[2 * i + u] * __expf(bm); }
              w[i] = pk2(e2[0], e2[1]); }
          *(LAS v4u*)(F.lds + L_ST + k * STR + sg * 16) = (v4u){w[0], w[1], w[2], w[3]}; }
        __syncthreads();
        if (F.wave < 3) { const int tt = F.wave ? 1 : 0, st = (F.wave == 2) ? 1 : 0; f32x16 acc = (f32x16){};
#pragma unroll
            for (int ks = 0; ks < 4; ++ks) { const bf16x8 a = *(const LAS bf16x8*)(F.lds + L_QT + (32 * tt + r32) * STR + 32 * ks + 16 * hi);
                const bf16x8 bb = *(const LAS bf16x8*)(F.lds + L_KT + (32 * st + r32) * STR + 32 * ks + 16 * hi);
                acc = __builtin_amdgcn_mfma_f32_32x32x16_bf16(a, bb, acc, 0, 0, 0); }
#pragma unroll
            for (int r = 0; r < 16; ++r) { const int t = 32 * tt + crow(r, hi), s = 32 * st + r32;
                *(LAS bf16*)(F.lds + L_AT + t * STR + s * 2) = (bf16)f2bf(s <= t ? acc[r] : 0.f); }
        } else if (F.wave == 3) {
#pragma unroll
            for (int r = 0; r < 16; ++r) *(LAS bf16*)(F.lds + L_AT + crow(r, hi) * STR + (32 + r32) * 2) = (bf16)0;
        }
        __syncthreads();
        if (F.wave < 4) { const int t0 = 16 * F.wave; f32x4 o[4];
#pragma unroll
            for (int vt = 0; vt < 4; ++vt) o[vt] = (f32x4){0.f, 0.f, 0.f, 0.f};
#pragma unroll
            for (int ks = 0; ks < 2; ++ks) { const bf16x8 aA = *(const LAS bf16x8*)(F.lds + L_AT + (t0 + l15) * STR + 64 * ks + 16 * kg);
                const bf16x8 aQ = *(const LAS bf16x8*)(F.lds + L_QT + (t0 + l15) * STR + 64 * ks + 16 * kg);
#pragma unroll
                for (int vt = 0; vt < 4; ++vt) { const bf16x8 bV = *(const LAS bf16x8*)(F.lds + L_VT + (16 * vt + l15) * STR + 64 * ks + 16 * kg);
                    const bf16x8 bS = *(const LAS bf16x8*)(F.lds + L_ST + (16 * vt + l15) * STR + 64 * ks + 16 * kg);
                    o[vt] = __builtin_amdgcn_mfma_f32_16x16x32_bf16(aA, bV, o[vt], 0, 0, 0);
                    o[vt] = __builtin_amdgcn_mfma_f32_16x16x32_bf16(aQ, bS, o[vt], 0, 0, 0); } }
            float ss[4];
#pragma unroll
            for (int r = 0; r < 4; ++r) { float s = (o[0][r] * o[0][r] + o[1][r] * o[1][r]) + (o[2][r] * o[2][r] + o[3][r] * o[3][r]);
                s += __shfl_xor(s, 1); s += __shfl_xor(s, 2); s += __shfl_xor(s, 4); s += __shfl_xor(s, 8); ss[r] = rsqrtf(s * (1.f / 64.f) + RMS_EPS); }
#pragma unroll
            for (int vt = 0; vt < 4; ++vt) { const int v = 16 * vt + l15; const float nwv = F_nw[h * 64 + v];
#pragma unroll
                for (int r = 0; r < 4; ++r) { const int t = t0 + 4 * kg + r; const float g = bf2f(F_HG[(size_t)(row0 + t) * AW + h * 64 + v]);
                    F_AR[(size_t)(row0 + t) * D + AW + h * 64 + v] = (bf16)f2bf(o[vt][r] * ss[r] * nwv * sigmoidf_(g)); } }
        }
        __syncthreads();
    }
}
}

template <class AM, class BMp, class Epi>
__device__ __forceinline__ void naive_gemm(Frame& F, const bf16* A, int lda, int M, const bf16* Bt, int ldb, int ntn, int K, AM amap, BMp bmap, Epi epi) {
    LAS float* As = (LAS float*)F.lds; LAS float* Bs = As + 64 * 33;
    const int tilesM = (M + 63) / 64, ty = F.tid >> 4, tx = F.tid & 15;
    for (int tile = blockIdx.x; tile < tilesM * ntn; tile += F.G) {
        const int tm = tile / ntn, tn = tile % ntn;
        float acc[2][4];
#pragma unroll
        for (int i = 0; i < 2; ++i)
#pragma unroll
            for (int j = 0; j < 4; ++j) acc[i][j] = 0.f;
        for (int k0 = 0; k0 < K; k0 += 32) {
#pragma unroll
            for (int i = 0; i < 4; ++i) { const int idx = F.tid + 512 * i, r = idx >> 5, kk = idx & 31, gr = tm * 64 + r;
                float v = 0.f; if (gr < M) { const int ar = amap(gr); v = bf2f(A[(size_t)ar * lda + k0 + kk]); }
                As[r * 33 + kk] = v;
                Bs[r * 33 + kk] = bf2f(Bt[(size_t)bmap(tn, r) * ldb + k0 + kk]); }
            __syncthreads();
#pragma unroll 8
            for (int kk = 0; kk < 32; ++kk) { const float a0 = As[ty * 33 + kk], a1 = As[(ty + 32) * 33 + kk];
#pragma unroll
                for (int j = 0; j < 4; ++j) { const float b = Bs[(tx + 16 * j) * 33 + kk]; acc[0][j] += a0 * b; acc[1][j] += a1 * b; } }
            __syncthreads();
        }
        epi(tm, tn, ty, tx, acc);
    }
}

__device__ __forceinline__ void naive_kmean(Frame& F) {
    const int gt = blockIdx.x * NT + F.tid, NGT = F.G * NT;
    for (int i = gt; i < 16 * 32 * 64; i += NGT) { const int d = i & 63, j = (i >> 6) & 31, bh = i >> 11, b = bh >> 3, h = bh & 7;
        const bf16* p = F_KB + ((size_t)(b * SEQ + j * 256)) * AW + h * 64 + d; float s = 0.f;
        for (int t = 0; t < 256; ++t) s += bf2f(p[(size_t)t * AW]);
        F_KMEAN[i] = s; }
}
__device__ __forceinline__ void naive_attn(Frame& F, bf16* ARdst) {
    const int NGT = F.G * NT;
    for (int gi = blockIdx.x * NT + F.tid; gi < 16 * SEQ; gi += NGT) {
        const int bh = gi >> 13, qi = gi & 8191, b = bh >> 3, h = bh & 7, n = qi >> 8;
        float q[64];
        { const GAS v4u* qp = (const GAS v4u*)(F_QB + ((size_t)(b * SEQ + qi)) * AW + h * 64);
#pragma unroll
          for (int c = 0; c < 8; ++c) { const v4u w = qp[c];
              q[8*c+0] = bf2f(w.x & 0xffff); q[8*c+1] = bf2f(w.x >> 16); q[8*c+2] = bf2f(w.y & 0xffff); q[8*c+3] = bf2f(w.y >> 16);
              q[8*c+4] = bf2f(w.z & 0xffff); q[8*c+5] = bf2f(w.z >> 16); q[8*c+6] = bf2f(w.w & 0xffff); q[8*c+7] = bf2f(w.w >> 16); } }
        int s0 = -1, s1 = -1, s2 = -1;
        const float* km = F_KMEAN + (size_t)bh * 32 * 64;
        for (int pass = 0; pass < 3; ++pass) {
            float best = -INFINITY; int bi = -1;
            for (int j = 0; j < n; ++j) { if (j == s0 || j == s1) continue; float g = 0.f;
#pragma unroll
                for (int d = 0; d < 64; ++d) g += q[d] * km[j * 64 + d];
                if (g > best) { best = g; bi = j; } }
            if (pass == 0) s0 = bi; else if (pass == 1) s1 = bi; else s2 = bi;
        }
        float m = -INFINITY, l = 0.f, o[64];
#pragma unroll
        for (int d = 0; d < 64; ++d) o[d] = 0.f;
        const float* bias = F_BIASN + h * 128;
        for (int bsel = 0; bsel < 4; ++bsel) {
            const int blk = bsel == 0 ? s0 : bsel == 1 ? s1 : bsel == 2 ? s2 : n;
            if (blk < 0) continue;
            const int ngrp = (bsel == 3) ? ((qi & 255) >> 3) + 1 : 32;
            for (int kg = 0; kg < ngrp; ++kg) {
                const int kp0 = blk * 256 + kg * 8; float s[8]; float gm = -INFINITY;
#pragma unroll
                for (int u = 0; u < 8; ++u) { const int kpos = kp0 + u;
                    const GAS v4u* kp = (const GAS v4u*)(F_KB + ((size_t)(b * SEQ + kpos)) * AW + h * 64); float dt = 0.f;
#pragma unroll
                    for (int c = 0; c < 8; ++c) { const v4u w = kp[c];
                        dt += q[8*c+0] * bf2f(w.x & 0xffff) + q[8*c+1] * bf2f(w.x >> 16) + q[8*c+2] * bf2f(w.y & 0xffff) + q[8*c+3] * bf2f(w.y >> 16)
                            + q[8*c+4] * bf2f(w.z & 0xffff) + q[8*c+5] * bf2f(w.z >> 16) + q[8*c+6] * bf2f(w.w & 0xffff) + q[8*c+7] * bf2f(w.w >> 16); }
                    const int dist = qi - kpos;
                    s[u] = (dist >= 0) ? dt * 0.125f + bias[dist > 127 ? 127 : dist] : -INFINITY;
                    gm = fmaxf(gm, s[u]); }
                const float mn = fmaxf(m, gm); const float alpha = __expf(m - mn); float p[8]; float ps = 0.f;
#pragma unroll
                for (int u = 0; u < 8; ++u) { p[u] = __expf(s[u] - mn); ps += p[u]; }
                l = l * alpha + ps; m = mn;
                const GAS v4u* vp = (const GAS v4u*)(F_VT + ((size_t)bh * 64) * SEQ + kp0);
#pragma unroll
                for (int d = 0; d < 64; ++d) { const v4u w = vp[(size_t)d * (SEQ / 8)];
                    o[d] = o[d] * alpha + p[0] * bf2f(w.x & 0xffff) + p[1] * bf2f(w.x >> 16) + p[2] * bf2f(w.y & 0xffff) + p[3] * bf2f(w.y >> 16)
                         + p[4] * bf2f(w.z & 0xffff) + p[5] * bf2f(w.z >> 16) + p[6] * bf2f(w.w & 0xffff) + p[7] * bf2f(w.w >> 16); }
            }
        }
        const float inv = 1.f / l;
        GAS unsigned* op = (GAS unsigned*)(ARdst + ((size_t)(b * SEQ + qi)) * D + h * 64);
#pragma unroll
        for (int d = 0; d < 64; d += 2) op[d >> 1] = pk2(o[d] * inv, o[d + 1] * inv);
    }
}
__device__ __forceinline__ void naive_hgrn(Frame& F) {
    if (F.wave != 0) return;
    for (int bh = blockIdx.x; bh < 16; bh += F.G) {
        const int b = bh >> 3, h = bh & 7, lane = F.lane;
        const float lb = F_LB[h * 64 + lane], nwv = F_nw[h * 64 + lane];
        float S[64];
#pragma unroll
        for (int k = 0; k < 64; ++k) S[k] = 0.f;
        LAS float* bc = (LAS float*)F.lds;
        for (int t0 = 0; t0 < SEQ; t0 += 8) {
#pragma unroll
            for (int u = 0; u < 8; ++u) { const size_t off = ((size_t)(b * SEQ + t0 + u)) * AW + h * 64 + lane;
                const float fl = bf2f(F_HF[off]), ql = bf2f(F_HQ[off]), vl = bf2f(F_HI[off]), gl = bf2f(F_HG[off]);
                const float f = lb + (1.f - lb) * sigmoidf_(fl);
                bc[u * 320 + lane] = f; bc[u * 320 + 64 + lane] = 1.f - f; bc[u * 320 + 128 + lane] = ql * sigmoidf_(ql);
                bc[u * 320 + 192 + lane] = vl; bc[u * 320 + 256 + lane] = sigmoidf_(gl); }
            LDS_WAIT(); asm volatile("" ::: "memory");
#pragma unroll 1
            for (int u = 0; u < 8; ++u) {
                const LAS float* pb = bc + u * 320;
                const float vv = pb[192 + lane], gs = pb[256 + lane];
                float o = 0.f;
#pragma unroll
                for (int k = 0; k < 64; k += 4) {
                    const f32x4 f4 = *(const LAS f32x4*)(pb + k), k4 = *(const LAS f32x4*)(pb + 64 + k), q4 = *(const LAS f32x4*)(pb + 128 + k);
                    S[k] = f4.x * S[k] + k4.x * vv; o += q4.x * S[k];
                    S[k + 1] = f4.y * S[k + 1] + k4.y * vv; o += q4.y * S[k + 1];
                    S[k + 2] = f4.z * S[k + 2] + k4.z * vv; o += q4.z * S[k + 2];
                    S[k + 3] = f4.w * S[k + 3] + k4.w * vv; o += q4.w * S[k + 3];
                    if ((k & 15) == 12) __builtin_amdgcn_sched_barrier(0); }
                const float ms = wave_sum(o * o) * (1.f / 64.f);
                const float r = o * rsqrtf(ms + RMS_EPS) * nwv * gs;
                F_AR[((size_t)(b * SEQ + t0 + u)) * D + AW + h * 64 + lane] = (bf16)f2bf(r);
            }
            LDS_WAIT(); asm volatile("" ::: "memory");
        }
    }
}

__device__ __forceinline__ void seg_bases(Frame& F, int (&base)[16], int (&cnt)[16]) {
    int acc = 0;
#pragma unroll
    for (int e = 0; e < 16; ++e) { cnt[e] = (int)F.ctl[CW_ECNT + e]; base[e] = acc; acc += (cnt[e] + 255) & ~255; }
}
__device__ __forceinline__ void p6_ln1_router(Frame& F) {
    LAS int* rinfo = (LAS int*)F.lds;
    LAS int* lcnt = rinfo + 256;
    LAS int* gbase = lcnt + 16;
    LAS int* lpos = gbase + 16;
    float* Y = F_out;
    for (int grp = F.vcu; grp < T / 64; grp += F.G) {
        if (F.tid < 16) lcnt[F.tid] = 0;
        __syncthreads();
        for (int i = 0; i < 8; ++i) {
            const int rl = F.wave * 8 + i, m = grp * 64 + rl;
            GAS f32x4* yr = (GAS f32x4*)(Y + (size_t)m * D) + F.lane;
            f32x4 v[4]; float s = 0.f;
#pragma unroll
            for (int j = 0; j < 4; ++j) { v[j] = yr[64 * j]; s += (v[j].x + v[j].y) + (v[j].z + v[j].w); }
            const float mean = wave_sum(s) * (1.f / D); float s2 = 0.f;
#pragma unroll
            for (int j = 0; j < 4; ++j) { v[j] = v[j] - mean; s2 += (v[j].x * v[j].x + v[j].y * v[j].y) + (v[j].z * v[j].z + v[j].w * v[j].w); }
            const float rstd = rsqrtf(wave_sum(s2) * (1.f / D) + LN_EPS);
            GAS v2u* o8 = (GAS v2u*)(F_X1B + (size_t)m * D) + F.lane;
            float racc[20];
#pragma unroll
            for (int k = 0; k < 20; ++k) racc[k] = 0.f;
#pragma unroll
            for (int j = 0; j < 4; ++j) { const int c0 = 4 * F.lane + 256 * j;
                const f32x4 g = *(const GAS f32x4*)(F_ln1g + c0), bb = *(const GAS f32x4*)(F_ln1b + c0);
                v[j] = v[j] * rstd * g + bb;
                yr[64 * j] = v[j]; v2u o; o.x = pk2(v[j].x, v[j].y); o.y = pk2(v[j].z, v[j].w); o8[64 * j] = o;
#pragma unroll
                for (int ii = 0; ii < 4; ++ii) { const GAS f32x4* wr = (const GAS f32x4*)(F_WR + (size_t)(c0 + ii) * 20); const float xv = v[j][ii];
#pragma unroll
                    for (int k4 = 0; k4 < 5; ++k4) { const f32x4 w = wr[k4]; racc[4*k4+0] += xv * w.x; racc[4*k4+1] += xv * w.y; racc[4*k4+2] += xv * w.z; racc[4*k4+3] += xv * w.w; } } }
#pragma unroll
            for (int k = 0; k < 20; ++k) racc[k] = wave_sum(racc[k]);
            if (F.lane == 0) {
                float gl[4]; int gi = 0; float gmx = -INFINITY;
#pragma unroll
                for (int g = 0; g < 4; ++g) { gl[g] = racc[g] + F_b_grp[g]; if (gl[g] > gmx) { gmx = gl[g]; gi = g; } }
                float gs = 0.f;
#pragma unroll
                for (int g = 0; g < 4; ++g) gs += __expf(gl[g] - gmx);
                const float gw = 1.f / gs;
                float el[4];
#pragma unroll
                for (int e = 0; e < 4; ++e) { float a = 0.f;
#pragma unroll
                    for (int g = 0; g < 4; ++g) a = (g == gi) ? racc[4 + 4 * g + e] : a;
                    el[e] = a + F_b_exp[gi * 4 + e]; }
                int e0 = 0; float m0 = -INFINITY;
#pragma unroll
                for (int e = 0; e < 4; ++e) if (el[e] > m0) { m0 = el[e]; e0 = e; }
                int e1 = 0; float m1 = -INFINITY;
#pragma unroll
                for (int e = 0; e < 4; ++e) if (e != e0 && el[e] > m1) { m1 = el[e]; e1 = e; }
                const float p1 = __expf(m1 - m0), w0 = gw / (1.f + p1), w1 = gw * p1 / (1.f + p1);
                rinfo[rl * 4 + 0] = gi * 4 + e0; rinfo[rl * 4 + 1] = gi * 4 + e1;
                rinfo[rl * 4 + 2] = __builtin_bit_cast(int, w0); rinfo[rl * 4 + 3] = __builtin_bit_cast(int, w1);
            }
        }
        __syncthreads();
        if (F.tid < 128) { const int rl = F.tid >> 1, s = F.tid & 1; lpos[F.tid] = atomicAdd((int*)&lcnt[rinfo[rl * 4 + s]], 1); }
        __syncthreads();
        if (F.tid < 16) gbase[F.tid] = (int)__hip_atomic_fetch_add(F.ctl + CW_ECNT + F.tid, (unsigned)lcnt[F.tid], RLX_AGENT);
        __syncthreads();
        if (F.tid < 128) { const int rl = F.tid >> 1, s = F.tid & 1, e = rinfo[rl * 4 + s], pos = gbase[e] + lpos[F.tid], m = grp * 64 + rl;
            const float w = __builtin_bit_cast(float, rinfo[rl * 4 + 2 + s]);
            F_ELIST[(size_t)e * T + pos] = m; F_EW[(size_t)e * T + pos] = w;
            F_TOKE[m * 2 + s] = e; F_TOKP[m * 2 + s] = pos; F_TOKW[m * 2 + s] = w; }
        __syncthreads();
    }
}
__device__ __forceinline__ void p9_final(Frame& F) {
    int base[16], cnt[16]; seg_bases(F, base, cnt);
    const int gw = F.vcu * NWAVES + F.wave, NGW = F.G * NWAVES;
    for (int m = gw; m < T; m += NGW) {
        int r0 = 0, r1 = 0; { const int e0 = F_TOKE[m * 2], e1 = F_TOKE[m * 2 + 1], p0 = F_TOKP[m * 2], p1 = F_TOKP[m * 2 + 1];
#pragma unroll
            for (int e = 0; e < 16; ++e) { r0 = (e == e0) ? base[e] + p0 : r0; r1 = (e == e1) ? base[e] + p1 : r1; } }
        GAS f32x4* xr = (GAS f32x4*)(F_out + (size_t)m * D) + F.lane;
        const GAS v2u* y0 = (const GAS v2u*)(F_YE + (size_t)r0 * D) + F.lane; const GAS v2u* y1 = (const GAS v2u*)(F_YE + (size_t)r1 * D) + F.lane;
        f32x4 v[4]; float s = 0.f;
#pragma unroll
        for (int j = 0; j < 4; ++j) { const f32x4 xv = xr[64 * j]; const v2u a = y0[64 * j], c = y1[64 * j];
            v[j].x = ALPHA * xv.x + bf2f(a.x & 0xffff) + bf2f(c.x & 0xffff); v[j].y = ALPHA * xv.y + bf2f(a.x >> 16) + bf2f(c.x >> 16);
            v[j].z = ALPHA * xv.z + bf2f(a.y & 0xffff) + bf2f(c.y & 0xffff); v[j].w = ALPHA * xv.w + bf2f(a.y >> 16) + bf2f(c.y >> 16);
            s += (v[j].x + v[j].y) + (v[j].z + v[j].w); }
        const float mean = wave_sum(s) * (1.f / D); float s2 = 0.f;
#pragma unroll
        for (int j = 0; j < 4; ++j) { v[j] = v[j] - mean; s2 += (v[j].x * v[j].x + v[j].y * v[j].y) + (v[j].z * v[j].z + v[j].w * v[j].w); }
        const float rstd = rsqrtf(wave_sum(s2) * (1.f / D) + LN_EPS);
#pragma unroll
        for (int j = 0; j < 4; ++j) { const int c0 = 4 * F.lane + 256 * j;
            const f32x4 g = *(const GAS f32x4*)(F_ln2g + c0), bb = *(const GAS f32x4*)(F_ln2b + c0);
#ifdef DBG_ATTN
            const float dsc = 1.f + 100.f * sqrtf(__builtin_bit_cast(float, (unsigned)F.ctl[9000]) / __builtin_bit_cast(float, (unsigned)F.ctl[9001]));
            xr[64 * j] = (v[j] * rstd * g + bb) * dsc; }
#else
            xr[64 * j] = v[j] * rstd * g + bb; }
#endif
    }
}

constexpr int MOETBL_OFF = LDSCTL_OFF + 1024;
__device__ __forceinline__ const LAS int* moe_tables(Frame& F) {
    LAS int* tbl = (LAS int*)(F.lds + MOETBL_OFF);
    if (F.tid == 0) { int acc = 0;
        for (int e = 0; e < 16; ++e) { const int c = (int)F.ctl[CW_ECNT + e]; tbl[e] = acc; tbl[32 + e] = c; acc += (c + 255) >> 8; }
        tbl[16] = acc; }
    __syncthreads();
    return tbl;
}
constexpr int NPHASE = 10;
__global__ void __launch_bounds__(NT, 2) fwd(Args args) {
    extern __shared__ __attribute__((aligned(16))) unsigned char lds[];
    Frame F;
    F.lds = (LAS unsigned char*)lds;
    F.tid = threadIdx.x; F.lane = F.tid & 63; F.wave = __builtin_amdgcn_readfirstlane(F.tid >> 6);
    F.G = gridDim.x; { const int bx = blockIdx.x; F.vcu = (F.G % 8 == 0) ? (bx % 8) * (F.G / 8) + bx / 8 : bx; }
    F.a = &args;
    F.ctl = (gu32*)(args.ws + WS_CTL);
    for (int u = F.tid; u < (LDS_BYTES - LDSCTL_OFF) / 4; u += NT) ((LAS unsigned*)(F.lds + LDSCTL_OFF))[u] = 0u;
    __syncthreads();
    XcdBarrier bar = xcd_barrier_post((unsigned*)(F.ctl + CW_BAR), (volatile LAS unsigned*)(F.lds + MISC_OFF) + 8);
    const int lo = args.ph_lo, hi = args.ph_hi;
#define IN(k) (lo <= (k) && (k) < hi)
#define SEAM(k) do { if (IN(k) && IN((k) + 1)) xcd_barrier(bar); } while (0)

    if (IN(0)) { p0_prologue(F); } SEAM(0);
#if OPT_GEMM
    if (IN(1)) {
        pg8::StaticOrder S; S.init(T, INW, D, F.G, (int)blockIdx.x, F_WIN_T); pg8::EpiInProj E{F_ws, F_KMEAN};
        pg8::gemm_phase<pg8::EpiInProj, pg8::StaticOrder, true>(F.lds, F_XB, D, S, E);
    } SEAM(1);
#else
    if (IN(1)) {
        naive_gemm(F, F_XB, D, T, F_WIN_T, D, INW / 64, D, [](int r) { return r; }, [](int tn, int c) { return tn * 64 + c; },
            [&](int tm, int tn, int ty, int tx, float (&acc)[2][4]) {
#pragma unroll
                for (int i = 0; i < 2; ++i)
#pragma unroll
                    for (int j = 0; j < 4; ++j) { const int row = tm * 64 + ty + 32 * i, col = tn * 64 + tx + 16 * j, grp = col >> 9, cc = col & 511;
                        const bf16 v = (bf16)f2bf(acc[i][j]);
                        if (grp == 2) { const int b = row >> 13, t = row & 8191; F_VT[((size_t)(b * 8 + (cc >> 6)) * 64 + (cc & 63)) * SEQ + t] = v; }
                        else ((bf16*)(F_ws + WS_PROJ + (size_t)grp * PROJ_SLOT))[(size_t)row * AW + cc] = v; }
            });
    } SEAM(1);
#endif
    if (IN(2)) {
#if !OPT_GEMM
        naive_kmean(F);
#if OPT_ATTN
        xcd_barrier(bar);
#endif
#endif
#if OPT_ATTN
        attn::x1_select(F);
#endif
#if OPT_HGRN
        hgrn::h1_local(F);
#endif
    } SEAM(2);
#if OPT_ATTN
#if OPT_HGRN
    if (IN(3)) { attn::x2_partials(F); hgrn::h2_scan(F); } SEAM(3);
#else
    if (IN(3)) { attn::x2_partials(F); naive_hgrn(F); } SEAM(3);
#endif
    if (IN(4)) { attn::x3_own_merge(F);
#if OPT_HGRN
        hgrn::h3_out(F);
#endif
#ifdef DBG_ATTN
        naive_attn(F, F_XB);
        xcd_barrier(bar);
        { float num = 0.f, den = 0.f;
          for (size_t i = (size_t)blockIdx.x * NT + F.tid; i < (size_t)T * 512; i += (size_t)F.G * NT) { const size_t o = (i >> 9) * D + (i & 511);
              const float a = bf2f(F_AR[o]), r = bf2f(F_XB[o]); num += (a - r) * (a - r); den += r * r; }
          num = wave_sum(num); den = wave_sum(den);
          if (F.lane == 0) { atomicAdd((float*)(F.ctl + 9000), num); atomicAdd((float*)(F.ctl + 9001), den); } }
#endif
    } SEAM(4);
#else
    if (IN(3)) { naive_attn(F, F_AR); naive_hgrn(F); } SEAM(3);
    if (IN(4)) { } SEAM(4);
#endif
#if OPT_GEMM
    if (IN(5)) {
        pg8::StaticOrder S; S.init(T, D, D, F.G, (int)blockIdx.x, F_WO_T); pg8::EpiOutProj E{F_x, F_out};
        pg8::gemm_phase<pg8::EpiOutProj, pg8::StaticOrder, true>(F.lds, F_AR, D, S, E);
    } SEAM(5);
#else
    if (IN(5)) {
        naive_gemm(F, F_AR, D, T, F_WO_T, D, D / 64, D, [](int r) { return r; }, [](int tn, int c) { return tn * 64 + c; },
            [&](int tm, int tn, int ty, int tx, float (&acc)[2][4]) {
#pragma unroll
                for (int i = 0; i < 2; ++i)
#pragma unroll
                    for (int j = 0; j < 4; ++j) { const size_t o = (size_t)(tm * 64 + ty + 32 * i) * D + tn * 64 + tx + 16 * j; F_out[o] = ALPHA * F_x[o] + acc[i][j]; }
            });
    } SEAM(5);
#endif
    if (IN(6)) { p6_ln1_router(F); } SEAM(6);
#if OPT_GEMM
    if (IN(7)) {
        const LAS int* tbl = moe_tables(F);
        pg8::MoeOrder S{tbl, F.G, F.vcu, D, F_ELIST, (const char*)F_WGU_T, (size_t)1024 * 1024 * 2, true}; pg8::EpiMoe1 E{F_HB};
        pg8::gemm_phase<pg8::EpiMoe1, pg8::MoeOrder, true>(F.lds, F_X1B, D, S, E);
    } SEAM(7);
    if (IN(8)) {
        const LAS int* tbl = moe_tables(F);
        pg8::MoeOrder S{tbl, F.G, F.vcu, DE, nullptr, (const char*)F_WD_T, (size_t)1024 * 512 * 2, false}; pg8::EpiMoe2 E{F_YE, F_EW, tbl};
        pg8::gemm_phase<pg8::EpiMoe2, pg8::MoeOrder, true>(F.lds, F_HB, DE, S, E);
    } SEAM(8);
#else
    if (IN(7)) {
        int base[16], cnt[16]; seg_bases(F, base, cnt);
        for (int e = 0; e < 16; ++e) {
            const int* el = F_ELIST + (size_t)e * T; const int be = base[e], ce = cnt[e];
            naive_gemm(F, F_X1B, D, ce, F_WGU_T + (size_t)e * 1024 * 1024, D, DE / 32, D, [&](int r) { return el[r]; },
                [](int tn, int c) { const int j = tn * 32 + (c & 31); return 256 * (j >> 7) + (j & 127) + ((c >> 5) ? 128 : 0); },
                [&](int tm, int tn, int ty, int tx, float (&acc)[2][4]) {
#pragma unroll
                    for (int i = 0; i < 2; ++i)
#pragma unroll
                        for (int j = 0; j < 2; ++j) { const int row = tm * 64 + ty + 32 * i; if (row < ce) { const float g = acc[i][j], u = acc[i][j + 2];
                            F_HB[(size_t)(be + row) * DE + tn * 32 + tx + 16 * j] = (bf16)f2bf(g * sigmoidf_(g) * u); } }
                });
        }
    } SEAM(7);
    if (IN(8)) {
        int base[16], cnt[16]; seg_bases(F, base, cnt);
        for (int e = 0; e < 16; ++e) {
            const int be = base[e], ce = cnt[e]; const float* ew = F_EW + (size_t)e * T;
            naive_gemm(F, F_HB + (size_t)be * DE, DE, ce, F_WD_T + (size_t)e * 1024 * 512, DE, D / 64, DE, [](int r) { return r; }, [](int tn, int c) { return tn * 64 + c; },
                [&](int tm, int tn, int ty, int tx, float (&acc)[2][4]) {
#pragma unroll
                    for (int i = 0; i < 2; ++i)
#pragma unroll
                        for (int j = 0; j < 4; ++j) { const int row = tm * 64 + ty + 32 * i; if (row < ce)
                            F_YE[(size_t)(be + row) * D + tn * 64 + tx + 16 * j] = (bf16)f2bf(acc[i][j] * ew[row]); }
                });
        }
    } SEAM(8);
#endif
    if (IN(9)) { p9_final(F); }
#undef IN
#undef SEAM
}

extern "C" void kernel_launch(void* const* d_in, const int* in_sizes, int n_in, void* d_out, int out_size, void* d_ws, size_t ws_size, hipStream_t stream) {
    static int grid = 0;
    if (grid == 0) {
        if (n_in != 17 || in_sizes[0] != T * D || out_size != T * D || ws_size < WS_END) { fprintf(stderr, "kernel_launch: unexpected shapes (n_in %d, in0 %d, out %d, ws %zu)\n", n_in, n_in > 0 ? in_sizes[0] : -1, out_size, ws_size); grid = -1; return; }
        int dev = 0, cus = 0;
        if (hipGetDevice(&dev) != hipSuccess || hipDeviceGetAttribute(&cus, hipDeviceAttributeMultiprocessorCount, dev) != hipSuccess) { grid = -1; return; }
        if (hipFuncSetAttribute((const void*)fwd, hipFuncAttributeMaxDynamicSharedMemorySize, LDS_BYTES) != hipSuccess) { fprintf(stderr, "kernel_launch: hipFuncSetAttribute failed\n"); grid = -1; return; }
        (void)hipGetLastError();
        grid = cus;
    }
    if (grid < 0) return;
    if (hipMemsetAsync((char*)d_ws + WS_CTL, 0, CTL_ZERO_BYTES, stream) != hipSuccess) return;
    Args a{};
    for (int i = 0; i < 17; ++i) a.in[i] = (const float*)d_in[i];
    a.out = (float*)d_out; a.ws = (unsigned char*)d_ws; a.ph_lo = 0; a.ph_hi = NPHASE;
    hipLaunchKernelGGL(fwd, dim3(grid), dim3(NT), LDS_BYTES, stream, a);
}
```

```cpp
#include <hip/hip_runtime.h>
#include <cstdio>
#include <cstdint>

#define GAS __attribute__((address_space(1)))
#define LAS __attribute__((address_space(3)))
typedef unsigned short bf16;
typedef unsigned v4u __attribute__((ext_vector_type(4)));
typedef unsigned v2u __attribute__((ext_vector_type(2)));
typedef float f32x4 __attribute__((ext_vector_type(4)));
typedef float f32x2 __attribute__((ext_vector_type(2)));
typedef GAS unsigned gu32;
#define RLX_AGENT __ATOMIC_RELAXED, __HIP_MEMORY_SCOPE_AGENT
#define LDS_WAIT() asm volatile("s_waitcnt lgkmcnt(0)" ::: "memory")
#define VM_WAIT() asm volatile("s_waitcnt vmcnt(0)" ::: "memory")

#ifndef OPT_GEMM
#define OPT_GEMM 1
#endif
#ifndef OPT_ATTN
#define OPT_ATTN 1
#endif
#ifndef OPT_HGRN
#define OPT_HGRN 1
#endif
constexpr int NWAVES = 8, NT = 512;
constexpr int BATCH = 2, SEQ = 8192, D = 1024, T = BATCH * SEQ;
constexpr int NH = 8, HD = 64, AW = 512, INW = 3584;
constexpr int NBLK = 32, MBLK = 256;
constexpr int NE = 16, DE = 512;
constexpr float ALPHA = 1.189207115002721f;
constexpr float LN_EPS = 1e-5f, RMS_EPS = 1e-6f;

constexpr size_t MiB = 1u << 20;
constexpr size_t WS_CTL = 0, CTL_ZERO_BYTES = 1 * MiB;
constexpr size_t WS_KMEAN = 256 * 1024;
constexpr size_t WS_TAB = 1 * MiB;
constexpr size_t TAB_WR = 0, TAB_LB = 96 * 1024, TAB_BIAS = 100 * 1024;
constexpr size_t WS_WIN_T = 2 * MiB, WS_WO_T = 10 * MiB;
constexpr size_t WS_XB = 12 * MiB;
constexpr size_t WS_PROJ = 44 * MiB, PROJ_SLOT = 16 * MiB;
constexpr size_t WS_H = 44 * MiB, WS_YE = 80 * MiB;
constexpr size_t WS_AR = 156 * MiB;
constexpr size_t WS_LIST = 188 * MiB, WS_ML = 196 * MiB, WS_DECAY = 200 * MiB;
constexpr size_t WS_ROUTE = 201 * MiB;
constexpr size_t RT_TOKE = 0, RT_TOKW = 128 * 1024, RT_TOKP = 256 * 1024, RT_ELIST = 512 * 1024, RT_EW = 512 * 1024 + MiB;
constexpr size_t WS_WGU_T = 205 * MiB, WS_WD_T = 237 * MiB, WS_END = 253 * MiB;
constexpr int HROWS = 36864;
constexpr int CW_TMO = 0, CW_CODE = 1, CW_BAR = 4096, CW_ECNT = 8192, CW_LCNT = 8256;

constexpr int RING_BYTES = 131072, LDSCTL_OFF = RING_BYTES, MISC_OFF = LDSCTL_OFF + 320, LDS_BYTES = 147456;

__device__ __forceinline__ float bf2f(unsigned b) { return __builtin_bit_cast(float, b << 16); }
__device__ __forceinline__ unsigned f2bf(float f) { unsigned u = __builtin_bit_cast(unsigned, f); return (u + 0x7fffu + ((u >> 16) & 1u)) >> 16; }
__device__ __forceinline__ unsigned pk2(float lo, float hi) { return f2bf(lo) | (f2bf(hi) << 16); }
__device__ __forceinline__ float wave_sum(float v) {
#pragma unroll
    for (int o = 1; o < 64; o <<= 1) v += __shfl_xor(v, o);
    return v;
}
__device__ __forceinline__ float sigmoidf_(float x) { return 1.f / (1.f + __expf(-x)); }

#define XB_TMO      128
#define XB_XCNT(j)  (256  + 64 * (j))
#define XB_XSUB(j)  (1280 + 64 * (j))
#define XB_XGEN(j)  (2304 + 64 * (j))
#define XB_TOP      3328
#define XB_TOPGEN   3392
#define XCD_BAR_WORDS 3456
#define XB_SPIN_CAP (1u << 18)
__device__ __forceinline__ unsigned xb_ld(unsigned* p)              { return __hip_atomic_load(p, __ATOMIC_RELAXED, __HIP_MEMORY_SCOPE_AGENT); }
__device__ __forceinline__ unsigned xb_add(unsigned* p, unsigned v) { return __hip_atomic_fetch_add(p, v, __ATOMIC_RELAXED, __HIP_MEMORY_SCOPE_AGENT); }
__device__ __forceinline__ unsigned xb_xcc_id() { return (unsigned)__builtin_amdgcn_s_getreg((3 << 11) | 20) & 0xFu; }
#define XB_SPIN(cond, bar) do { unsigned _sp = 0; while (cond) { __builtin_amdgcn_s_sleep(1); \
    if ((++_sp & 255u) == 0u) { if (xb_ld(&(bar)[XB_TMO])) break; if (_sp > XB_SPIN_CAP) { atomicAdd(&(bar)[XB_TMO], 1u); break; } } } } while (0)
struct XcdBarrier { unsigned* bar; unsigned x; volatile LAS unsigned* st; };
__device__ __forceinline__ XcdBarrier xcd_barrier_post(unsigned* bar, volatile LAS unsigned* st) {
    XcdBarrier b; b.bar = bar; b.x = xb_xcc_id(); b.st = st;
    if (threadIdx.x == 0) (void)xb_add(&bar[XB_XCNT(b.x)], 1u);
    return b;
}
__device__ __forceinline__ void xcd_barrier_complete(unsigned* bar, unsigned x, unsigned& nloc, unsigned& nx) {
    const unsigned G = gridDim.x * gridDim.y * gridDim.z;
    unsigned sum, cnt, mine, sp = 0u;
    for (;;) {
        sum = 0u; cnt = 0u; mine = 0u;
#pragma unroll
        for (unsigned j = 0; j < 16; ++j) { const unsigned c = xb_ld(&bar[XB_XCNT(j)]); sum += c; cnt += (c > 0u) ? 1u : 0u; mine = (j == x) ? c : mine; }
        if (sum == G) break;
        __builtin_amdgcn_s_sleep(1);
        if ((++sp & 255u) == 0u) { if (xb_ld(&bar[XB_TMO])) break; if (sp > XB_SPIN_CAP) { atomicAdd(&bar[XB_TMO], 1u); break; } }
    }
    nloc = mine > 0u ? mine : 1u; nx = cnt > 0u ? cnt : 1u;
}
__device__ __forceinline__ void xcd_barrier(const XcdBarrier& b) {
    asm volatile("s_waitcnt vmcnt(0)" ::: "memory");
    __syncthreads();
    if (threadIdx.x == 0) {
        unsigned* bar = b.bar;
        __builtin_amdgcn_s_waitcnt(0);
        unsigned nloc = b.st[0], nx = b.st[1];
        if (nloc == 0u) { xcd_barrier_complete(bar, b.x, nloc, nx); b.st[0] = nloc; b.st[1] = nx; }
        const unsigned old = xb_add(&bar[XB_XSUB(b.x)], 1u);
        const unsigned gen = old / nloc;
        if (old + 1u == (gen + 1u) * nloc) {
            __builtin_amdgcn_fence(__ATOMIC_RELEASE, "agent");
            asm volatile("s_waitcnt vmcnt(0)" ::: "memory");
            const unsigned og = xb_add(&bar[XB_TOP], 1u);
            const unsigned tg = og / nx;
            if (og + 1u == (tg + 1u) * nx) xb_add(&bar[XB_TOPGEN], 1u);
            else XB_SPIN(xb_ld(&bar[XB_TOPGEN]) == tg, bar);
            __builtin_amdgcn_fence(__ATOMIC_ACQUIRE, "agent");
            xb_add(&bar[XB_XGEN(b.x)], 1u);
            asm volatile("s_waitcnt vmcnt(0)" ::: "memory");
        } else {
            XB_SPIN(xb_ld(&bar[XB_XGEN(b.x)]) == gen, bar);
            __builtin_amdgcn_fence(__ATOMIC_ACQUIRE, "agent");
            asm volatile("s_waitcnt vmcnt(0)" ::: "memory");
        }
    }
    __syncthreads();
}

struct Args { const float* in[17]; float* out; unsigned char* ws; int ph_lo, ph_hi; };
struct Frame {
    LAS unsigned char* lds;
    gu32* ctl;
    int tid, lane, wave, vcu, G;
    const Args* a;
};
#define F_IN(i) (F.a->in[i])
#define F_x F_IN(0)
#define F_w_in F_IN(1)
#define F_t5 F_IN(2)
#define F_lbl F_IN(3)
#define F_nw F_IN(4)
#define F_w_o F_IN(5)
#define F_ln1g F_IN(6)
#define F_ln1b F_IN(7)
#define F_w_grp F_IN(8)
#define F_b_grp F_IN(9)
#define F_w_exp F_IN(10)
#define F_b_exp F_IN(11)
#define F_w_gate F_IN(12)
#define F_w_up F_IN(13)
#define F_w_down F_IN(14)
#define F_ln2g F_IN(15)
#define F_ln2b F_IN(16)
#define F_out (F.a->out)
#define F_ws (F.a->ws)
#define F_KMEAN ((float*)(F_ws + WS_KMEAN))
#define F_WR ((float*)(F_ws + WS_TAB + TAB_WR))
#define F_LB ((float*)(F_ws + WS_TAB + TAB_LB))
#define F_BIASN ((float*)(F_ws + WS_TAB + TAB_BIAS))
#define F_WIN_T ((bf16*)(F_ws + WS_WIN_T))
#define F_WO_T ((bf16*)(F_ws + WS_WO_T))
#define F_WGU_T ((bf16*)(F_ws + WS_WGU_T))
#define F_WD_T ((bf16*)(F_ws + WS_WD_T))
#define F_XB ((bf16*)(F_ws + WS_XB))
#define F_X1B ((bf16*)(F_ws + WS_XB))
#define F_QB ((bf16*)(F_ws + WS_PROJ))
#define F_KB ((bf16*)(F_ws + WS_PROJ + PROJ_SLOT))
#define F_VT ((bf16*)(F_ws + WS_PROJ + 2 * PROJ_SLOT))
#define F_HQ ((bf16*)(F_ws + WS_PROJ + 3 * PROJ_SLOT))
#define F_HF ((bf16*)(F_ws + WS_PROJ + 4 * PROJ_SLOT))
#define F_HI ((bf16*)(F_ws + WS_PROJ + 5 * PROJ_SLOT))
#define F_HG ((bf16*)(F_ws + WS_PROJ + 6 * PROJ_SLOT))
#define F_AR ((bf16*)(F_ws + WS_AR))
#define F_HB ((bf16*)(F_ws + WS_H))
#define F_YE ((bf16*)(F_ws + WS_YE))
#define F_TOKE ((int*)(F_ws + WS_ROUTE + RT_TOKE))
#define F_TOKW ((float*)(F_ws + WS_ROUTE + RT_TOKW))
#define F_TOKP ((int*)(F_ws + WS_ROUTE + RT_TOKP))
#define F_ELIST ((int*)(F_ws + WS_ROUTE + RT_ELIST))
#define F_EW ((float*)(F_ws + WS_ROUTE + RT_EW))

template <class RM>
__device__ __forceinline__ void p0_transpose_item(const float* W, int K, int N, bf16* WT, LAS float* scr, int item, int lane, RM rm) {
    const int nblk = N / 32, kb = item / nblk, nb = item % nblk, k0 = 64 * kb, n0 = 32 * nb;
#pragma unroll 8
    for (int i = 0; i < 32; ++i) { const int kk = 2 * i + (lane >> 5); scr[kk * 33 + (lane & 31)] = W[(size_t)(k0 + kk) * N + n0 + (lane & 31)]; }
    LDS_WAIT(); asm volatile("" ::: "memory");
    const int c = lane & 7;
#pragma unroll
    for (int j = 0; j < 4; ++j) { const int n = (lane >> 3) + 8 * j; const LAS float* s = scr + (8 * c) * 33 + n;
        v4u o; o.x = pk2(s[0 * 33], s[1 * 33]); o.y = pk2(s[2 * 33], s[3 * 33]); o.z = pk2(s[4 * 33], s[5 * 33]); o.w = pk2(s[6 * 33], s[7 * 33]);
        *(GAS v4u*)(WT + (size_t)rm(n0 + n) * K + k0 + 8 * c) = o; }
    LDS_WAIT(); asm volatile("" ::: "memory");
}
__device__ __forceinline__ void p0_prologue(Frame& F) {
    LAS float* scr = (LAS float*)(F.lds + F.wave * 16384);
    const int gw = F.vcu * NWAVES + F.wave, NGW = F.G * NWAVES;
    constexpr int I_IN = 16 * 112, I_O = 16 * 32, I_G = 16 * 256, I_U = 16 * 256, I_D = 16 * 256;
    constexpr int NITEMS = I_IN + I_O + I_G + I_U + I_D;
    for (int it = gw; it < NITEMS; it += NGW) {
        int r = it;
        if (r < I_IN) { p0_transpose_item(F_w_in, D, INW, F_WIN_T, scr, r, F.lane, [](int n) { return n; }); continue; } r -= I_IN;
        if (r < I_O) { p0_transpose_item(F_w_o, D, D, F_WO_T, scr, r, F.lane, [](int n) { return n; }); continue; } r -= I_O;
        if (r < I_G) { const int e = r >> 8; p0_transpose_item(F_w_gate + (size_t)e * D * DE, D, DE, F_WGU_T + (size_t)e * 1024 * 1024, scr, r & 255, F.lane, [](int n) { return 256 * (n >> 7) + (n & 127); }); continue; } r -= I_G;
        if (r < I_U) { const int e = r >> 8; p0_transpose_item(F_w_up + (size_t)e * D * DE, D, DE, F_WGU_T + (size_t)e * 1024 * 1024, scr, r & 255, F.lane, [](int n) { return 256 * (n >> 7) + 128 + (n & 127); }); continue; } r -= I_U;
        { const int e = r >> 8; p0_transpose_item(F_w_down + (size_t)e * DE * D, DE, D, F_WD_T + (size_t)e * 1024 * 512, scr, r & 255, F.lane, [](int n) { return n; }); }
    }
    for (int m = gw; m < T; m += NGW) {
        const GAS f32x4* xr = (const GAS f32x4*)(F_x + (size_t)m * D) + F.lane;
        GAS v2u* o8 = (GAS v2u*)(F_XB + (size_t)m * D) + F.lane;
#pragma unroll
        for (int j = 0; j < 4; ++j) { const f32x4 v = xr[64 * j]; v2u o; o.x = pk2(v.x, v.y); o.y = pk2(v.z, v.w); o8[64 * j] = o; }
    }
    const int gt = blockIdx.x * NT + F.tid, NGT = F.G * NT;
    for (int i = gt; i < 1024 * 20; i += NGT) { const int k = i >> 10, c = i & 1023;
        F_WR[i] = (k < 4) ? F_w_grp[c * 4 + k] : F_w_exp[((size_t)((k - 4) >> 2) * 1024 + c) * 4 + ((k - 4) & 3)]; }
    for (int i = gt; i < 512; i += NGT) { const float l0 = F_lbl[i], l1 = F_lbl[512 + i]; F_LB[i] = 1.f / (1.f + __expf(l1 - l0)); }
    for (int i = gt; i < 8 * 128; i += NGT) { const int h = i >> 7, n = i & 127; int bk;
        if (n < 16) bk = n; else { bk = 16 + (int)(logf((float)n / 16.f) / logf(8.f) * 16.f); bk = bk > 31 ? 31 : bk; }
        F_BIASN[i] = F_t5[bk * 8 + h]; }
}

namespace pg8 {
typedef short bf16x8 __attribute__((ext_vector_type(8)));
typedef unsigned u32x4 __attribute__((ext_vector_type(4)));
constexpr int BM = 256, BK = 64, HALF = 128, HTB = HALF * BK * 2, STAGE_BYTES = 8 * HTB, NXCD = 8, WGM = 8;
__device__ __forceinline__ int lds_byte(int r, int c) { const int st = (r >> 4) * 2 + (c >> 5), rr = r & 15, cc = c & 31, ob = rr * 64 + cc * 2; return st * 1024 + (ob ^ (((ob >> 9) & 1) << 5)); }
__device__ __forceinline__ void stage_rc(int b, int& R, int& C) { const int st = b / 1024, sb = b % 1024, swz = sb ^ (((sb >> 9) & 1) << 5); R = (st >> 1) * 16 + swz / 64; C = (st & 1) * 32 + (swz % 64) / 2; }
__device__ __forceinline__ int perm32(int rho) { const int n = rho >> 4, i = rho & 15; return 8 * (i >> 2) + 4 * n + (i & 3); }
struct Unit { int pm, pn, e, rows; };
__device__ __forceinline__ unsigned cvt_pk_bf16(float lo, float hi) { unsigned r; asm volatile("v_cvt_pk_bf16_f32 %0, %1, %2" : "=v"(r) : "v"(lo), "v"(hi)); return r; }

struct StaticOrder {
    int nM, nN, nwg, G, c, K; const char* Bt;
    __device__ void init(int M, int N, int K_, int G_, int c_, const void* Bt_) { nM = M / BM; nN = N / BM; nwg = nM * nN; G = G_; c = c_; K = K_; Bt = (const char*)Bt_; }
    __device__ __forceinline__ bool next(int i, Unit& u) const {
        const long L = (long)i * G + c; if (L >= nwg) return false;
        int wgid = (int)L; { const int q = nwg / NXCD, r = nwg % NXCD, xcd = wgid % NXCD, off = wgid / NXCD; wgid = (xcd < r ? xcd * (q + 1) : r * (q + 1) + (xcd - r) * q) + off; }
        const int nig = WGM * nN, gid = wgid / nig, fm = gid * WGM, gsz = (nM - fm) < WGM ? (nM - fm) : WGM;
        u.pm = fm + ((wgid % nig) % gsz); u.pn = (wgid % nig) / gsz; u.e = 0; u.rows = 256; return true;
    }
    __device__ __forceinline__ int arow(const Unit& u, int r) const { return u.pm * BM + r; }
    __device__ __forceinline__ const char* bptr(const Unit& u) const { return Bt + (size_t)u.pn * BM * K * 2; }
};

template <class Epi, class Sched, bool ALIGN_EPI>
__device__ __forceinline__ void gemm_phase(LAS unsigned char* lds, const bf16* Aptr, const int K, const Sched& S, const Epi& E) {
    const int tid = threadIdx.x, wid = __builtin_amdgcn_readfirstlane(tid >> 6), lane = tid & 63, wr = wid >> 2, wc = wid & 3, fr = lane & 15, fq = lane >> 4;
    const int nt = K / BK;
    int RA[2]; unsigned CA2[2], voffB[2];
#pragma unroll
    for (int i = 0; i < 2; ++i) { int R, C; stage_rc(tid * 16 + i * 8192, R, C); const int Rb = Epi::PERM ? ((R & ~31) + perm32(R & 31)) : R;
        RA[i] = R; CA2[i] = (unsigned)C * 2u; voffB[i] = (unsigned)(Rb * K + C) * 2u; }
    const size_t kstep = (size_t)(BK * 2);
    const size_t hstep = (size_t)HALF * K * 2;
    const unsigned ldsw = (unsigned)wid * 1024u;
    const int aoff = lds_byte(wr * 64 + fr, fq * 8), boff = lds_byte(wc * 32 + fr, fq * 8);
    const char* Ab = (const char*)Aptr;
    const unsigned rowb = (unsigned)K * 2u;
#define PG8_SA(b, h) (((b) * 2 + (h)) * HTB)
#define PG8_SB(b, h) ((4 + (b) * 2 + (h)) * HTB)
#define PG8_STAGE_B(bufoff, gbase) do { _Pragma("unroll") for (int _i = 0; _i < 2; ++_i) \
        __builtin_amdgcn_global_load_lds((const unsigned*)((const char*)(gbase) + voffB[_i]), (LAS unsigned*)(lds + (bufoff) + ldsw + _i * 8192), 16, 0, 0); } while (0)
#define PG8_STAGE_A(bufoff, kb, o0, o1) do { \
        __builtin_amdgcn_global_load_lds((const unsigned*)(Ab + (kb) + (o0)), (LAS unsigned*)(lds + (bufoff) + ldsw), 16, 0, 0); \
        __builtin_amdgcn_global_load_lds((const unsigned*)(Ab + (kb) + (o1)), (LAS unsigned*)(lds + (bufoff) + ldsw + 8192), 16, 0, 0); } while (0)
#define PG8_LDA(dst, b, h) do { _Pragma("unroll") for (int m = 0; m < 4; ++m) _Pragma("unroll") for (int k = 0; k < 2; ++k) dst[m][k] = *(const LAS bf16x8*)(lds + PG8_SA(b, h) + aoff + m * 2048 + k * 1024); } while (0)
#define PG8_LDB(dst, b, h) do { _Pragma("unroll") for (int n = 0; n < 2; ++n) _Pragma("unroll") for (int k = 0; k < 2; ++k) dst[n][k] = *(const LAS bf16x8*)(lds + PG8_SB(b, h) + boff + n * 2048 + k * 1024); } while (0)
#define PG8_MMA(ai, bj, At, Bt) do { __builtin_amdgcn_s_setprio(1); _Pragma("unroll") for (int m = 0; m < 4; ++m) _Pragma("unroll") for (int n = 0; n < 2; ++n) _Pragma("unroll") for (int k = 0; k < 2; ++k) \
        acc[ai][bj][m][n] = __builtin_amdgcn_mfma_f32_16x16x32_bf16(Bt[n][k], At[m][k], acc[ai][bj][m][n], 0, 0, 0); __builtin_amdgcn_s_setprio(0); } while (0)
#define PG8_WAIT_V(n) asm volatile("s_waitcnt vmcnt(" #n ")" ::: "memory")
#define PG8_WAIT_L(n) asm volatile("s_waitcnt lgkmcnt(" #n ")" ::: "memory")
#define PG8_BAR __builtin_amdgcn_s_barrier()
#define PG8_SCHED __builtin_amdgcn_sched_barrier(0)
#define PG8_OFFS(dst, u) do { _Pragma("unroll") for (int _h = 0; _h < 2; ++_h) _Pragma("unroll") for (int _i = 0; _i < 2; ++_i) dst[_h][_i] = (unsigned)S.arow(u, _h * HALF + RA[_i]) * rowb + CA2[_i]; } while (0)
    Unit cur, nxt; int ui = 0;
    if (!S.next(0, cur)) return;
    f32x4 acc[2][2][4][2];
#pragma unroll
    for (int a = 0; a < 2; ++a)
#pragma unroll
        for (int b = 0; b < 2; ++b)
#pragma unroll
            for (int m = 0; m < 4; ++m)
#pragma unroll
                for (int n = 0; n < 2; ++n) acc[a][b][m][n] = (f32x4){0.f, 0.f, 0.f, 0.f};
    bf16x8 At[4][2], B0[2][2], B1[2][2];
    unsigned offC[2][2], offN[2][2];
    PG8_OFFS(offC, cur);
    const char* cB = S.bptr(cur);
    PG8_STAGE_B(PG8_SB(0, 0), cB); PG8_STAGE_B(PG8_SB(0, 1), cB + hstep); PG8_STAGE_A(PG8_SA(0, 0), 0, offC[0][0], offC[0][1]); PG8_STAGE_A(PG8_SA(0, 1), 0, offC[1][0], offC[1][1]);
    if (wr == 1) PG8_BAR;
    PG8_WAIT_V(2); PG8_BAR;
    PG8_STAGE_B(PG8_SB(1, 0), cB + kstep); PG8_STAGE_A(PG8_SA(1, 0), kstep, offC[0][0], offC[0][1]); PG8_STAGE_B(PG8_SB(1, 1), cB + hstep + kstep);
    PG8_WAIT_V(6); PG8_BAR;
    for (;;) {
        const bool has_next = S.next(ui + 1, nxt);
        const char* nB = cB;
        if (has_next) { PG8_OFFS(offN, nxt); nB = S.bptr(nxt); }
        else {
#pragma unroll
            for (int _h = 0; _h < 2; ++_h)
#pragma unroll
                for (int _i = 0; _i < 2; ++_i) offN[_h][_i] = offC[_h][_i]; }
        for (int t = 0; t < nt; t += 2) {
            const bool last = (t == nt - 2);
            const size_t k1 = (size_t)(t + 1) * kstep;
            const size_t k2 = last ? 0 : (size_t)(t + 2) * kstep, k3 = k2 + kstep;
            const char* b2 = last ? nB : cB + (size_t)(t + 2) * kstep; const char* b3 = b2 + kstep;
            const unsigned o00 = last ? offN[0][0] : offC[0][0], o01 = last ? offN[0][1] : offC[0][1], o10 = last ? offN[1][0] : offC[1][0], o11 = last ? offN[1][1] : offC[1][1];
            PG8_LDB(B0, 0, 0); PG8_LDB(B1, 0, 1); PG8_SCHED; PG8_LDA(At, 0, 0); PG8_STAGE_A(PG8_SA(1, 1), k1, offC[1][0], offC[1][1]);
            PG8_WAIT_V(8); PG8_WAIT_L(0); PG8_BAR; PG8_MMA(0, 0, At, B0); PG8_MMA(0, 1, At, B1); PG8_BAR; PG8_SCHED;
            PG8_LDA(At, 0, 1); PG8_STAGE_B(PG8_SB(0, 0), b2); PG8_STAGE_B(PG8_SB(0, 1), b2 + hstep); PG8_STAGE_A(PG8_SA(0, 0), k2, o00, o01);
            PG8_WAIT_V(8); PG8_WAIT_L(0); PG8_BAR; PG8_MMA(1, 0, At, B0); PG8_MMA(1, 1, At, B1); PG8_BAR; PG8_SCHED;
            PG8_LDB(B0, 1, 0); PG8_LDB(B1, 1, 1); PG8_SCHED; PG8_LDA(At, 1, 0); PG8_STAGE_A(PG8_SA(0, 1), k2, o10, o11);
            PG8_WAIT_V(8); PG8_WAIT_L(0); PG8_BAR; PG8_MMA(0, 0, At, B0); PG8_MMA(0, 1, At, B1); PG8_BAR; PG8_SCHED;
            PG8_LDA(At, 1, 1); PG8_STAGE_B(PG8_SB(1, 0), b3); PG8_STAGE_B(PG8_SB(1, 1), b3 + hstep); PG8_STAGE_A(PG8_SA(1, 0), k3, o00, o01);
            PG8_WAIT_V(8); PG8_WAIT_L(0); PG8_BAR; PG8_MMA(1, 0, At, B0); PG8_MMA(1, 1, At, B1); PG8_BAR; PG8_SCHED;
        }
        if constexpr (ALIGN_EPI) { if (wr == 0) PG8_BAR; }
        E(acc, cur, wr, wc, fr, fq);
        if (!has_next) break;
#pragma unroll
        for (int a = 0; a < 2; ++a)
#pragma unroll
            for (int b = 0; b < 2; ++b)
#pragma unroll
                for (int m = 0; m < 4; ++m)
#pragma unroll
                    for (int n = 0; n < 2; ++n) acc[a][b][m][n] = (f32x4){0.f, 0.f, 0.f, 0.f};
        cur = nxt; cB = nB; ++ui;
#pragma unroll
        for (int _h = 0; _h < 2; ++_h)
#pragma unroll
            for (int _i = 0; _i < 2; ++_i) offC[_h][_i] = offN[_h][_i];
        if constexpr (ALIGN_EPI) { if (wr == 1) PG8_BAR; }
    }
    PG8_WAIT_V(0);
    if constexpr (!ALIGN_EPI) { if (wr == 0) PG8_BAR; }
    PG8_BAR;
#undef PG8_SA
#undef PG8_SB
#undef PG8_STAGE_A
#undef PG8_STAGE_B
#undef PG8_LDA
#undef PG8_LDB
#undef PG8_MMA
#undef PG8_WAIT_V
#undef PG8_WAIT_L
#undef PG8_BAR
#undef PG8_SCHED
#undef PG8_OFFS
}

struct EpiInProj {
    static constexpr bool PERM = true;
    unsigned char* ws; float* kmean;
    __device__ __forceinline__ void operator()(const f32x4 (&acc)[2][2][4][2], const Unit& u, int wr, int wc, int fr, int fq) const {
        const int grp = u.pn >> 1, colt = (u.pn & 1) * 256, row0 = u.pm * BM + wr * 64 + fr, col0 = colt + wc * 32 + 8 * fq;
        if (grp != 2) {
            bf16* base = (bf16*)(ws + WS_PROJ + (size_t)grp * PROJ_SLOT);
#pragma unroll
            for (int ai = 0; ai < 2; ++ai)
#pragma unroll
                for (int m = 0; m < 4; ++m) { bf16* rowp = base + (size_t)(row0 + ai * HALF + m * 16) * AW + col0;
#pragma unroll
                    for (int bj = 0; bj < 2; ++bj) { const f32x4 v0 = acc[ai][bj][m][0], v1 = acc[ai][bj][m][1];
                        u32x4 w; w.x = cvt_pk_bf16(v0[0], v0[1]); w.y = cvt_pk_bf16(v0[2], v0[3]); w.z = cvt_pk_bf16(v1[0], v1[1]); w.w = cvt_pk_bf16(v1[2], v1[3]);
                        *(u32x4*)(rowp + bj * HALF) = w; } }
            if (grp == 1) {
                const int b = u.pm >> 5, jb = u.pm & 31;
#pragma unroll
                for (int bj = 0; bj < 2; ++bj)
#pragma unroll
                    for (int n = 0; n < 2; ++n)
#pragma unroll
                        for (int j = 0; j < 4; ++j) { float s = 0.f;
#pragma unroll
                            for (int ai = 0; ai < 2; ++ai)
#pragma unroll
                                for (int m = 0; m < 4; ++m) s += acc[ai][bj][m][n][j];
                            s += __shfl_xor(s, 1); s += __shfl_xor(s, 2); s += __shfl_xor(s, 4); s += __shfl_xor(s, 8);
                            if (fr == 0) { const int cc = col0 + bj * HALF + 4 * n + j; atomicAdd(kmean + ((size_t)((b * 8 + (cc >> 6)) * 32 + jb)) * 64 + (cc & 63), s); } }
            }
        } else {
            bf16* vt = (bf16*)(ws + WS_PROJ + 2 * PROJ_SLOT); const int b = u.pm >> 5; const bool odd = fr & 1;
#pragma unroll
            for (int ai = 0; ai < 2; ++ai)
#pragma unroll
                for (int m = 0; m < 4; ++m) { const int t = ((row0 + ai * HALF + m * 16) & (SEQ - 1)) - (odd ? 1 : 0);
#pragma unroll
                    for (int bj = 0; bj < 2; ++bj)
#pragma unroll
                        for (int p = 0; p < 4; ++p) { const float a = acc[ai][bj][m][p >> 1][(2 * p) & 3], bb = acc[ai][bj][m][p >> 1][(2 * p + 1) & 3];
                            const float recv = __shfl_xor(odd ? a : bb, 1);
                            const int col = col0 + bj * HALF + 2 * p + (odd ? 1 : 0);
                            *(unsigned*)(vt + ((size_t)((b * 8 + (col >> 6)) * 64 + (col & 63))) * SEQ + t) = odd ? cvt_pk_bf16(recv, bb) : cvt_pk_bf16(a, recv); } }
        }
    }
};
struct EpiOutProj {
    static constexpr bool PERM = false;
    const float* x; float* y;
    __device__ __forceinline__ void operator()(const f32x4 (&acc)[2][2][4][2], const Unit& u, int wr, int wc, int fr, int fq) const {
        const int col0 = u.pn * BM + wc * 32 + 4 * fq;
#pragma unroll
        for (int ai = 0; ai < 2; ++ai)
#pragma unroll
            for (int m = 0; m < 4; ++m) { const size_t off = (size_t)(u.pm * BM + ai * HALF + wr * 64 + m * 16 + fr) * D + col0;
#pragma unroll
                for (int bj = 0; bj < 2; ++bj)
#pragma unroll
                    for (int n = 0; n < 2; ++n) { const f32x4 xv = *(const f32x4*)(x + off + bj * HALF + n * 16); *(f32x4*)(y + off + bj * HALF + n * 16) = xv * ALPHA + acc[ai][bj][m][n]; } }
    }
};
struct EpiMoe1 {
    static constexpr bool PERM = true;
    bf16* H;
    __device__ __forceinline__ void operator()(const f32x4 (&acc)[2][2][4][2], const Unit& u, int wr, int wc, int fr, int fq) const {
#pragma unroll
        for (int ai = 0; ai < 2; ++ai)
#pragma unroll
            for (int m = 0; m < 4; ++m) { const int rl = ai * HALF + wr * 64 + m * 16 + fr;
                if (rl < u.rows) { u32x4 w; float h[8];
#pragma unroll
                    for (int n = 0; n < 2; ++n)
#pragma unroll
                        for (int j = 0; j < 4; ++j) { const float g = acc[ai][0][m][n][j], up = acc[ai][1][m][n][j]; h[4 * n + j] = g * up / (1.f + __expf(-g)); }
                    w.x = cvt_pk_bf16(h[0], h[1]); w.y = cvt_pk_bf16(h[2], h[3]); w.z = cvt_pk_bf16(h[4], h[5]); w.w = cvt_pk_bf16(h[6], h[7]);
                    *(u32x4*)(H + (size_t)(u.pm * BM + rl) * DE + u.pn * 128 + wc * 32 + 8 * fq) = w; } }
    }
};
struct EpiMoe2 {
    static constexpr bool PERM = true;
    bf16* YE; const float* EW; const LAS int* tbl;
    __device__ __forceinline__ void operator()(const f32x4 (&acc)[2][2][4][2], const Unit& u, int wr, int wc, int fr, int fq) const {
        const int pos0 = (u.pm - tbl[u.e]) * BM;
#pragma unroll
        for (int ai = 0; ai < 2; ++ai)
#pragma unroll
            for (int m = 0; m < 4; ++m) { const int rl = ai * HALF + wr * 64 + m * 16 + fr;
                if (rl < u.rows) { const float wt = EW[(size_t)u.e * T + pos0 + rl];
#pragma unroll
                    for (int bj = 0; bj < 2; ++bj) { const f32x4 v0 = acc[ai][bj][m][0] * wt, v1 = acc[ai][bj][m][1] * wt;
                        u32x4 w; w.x = cvt_pk_bf16(v0[0], v0[1]); w.y = cvt_pk_bf16(v0[2], v0[3]); w.z = cvt_pk_bf16(v1[0], v1[1]); w.w = cvt_pk_bf16(v1[2], v1[3]);
                        *(u32x4*)(YE + (size_t)(u.pm * BM + rl) * D + u.pn * BM + bj * HALF + wc * 32 + 8 * fq) = w; } } }
    }
};
struct MoeOrder {
    const LAS int* tbl; int G, c, K; const int* elist; const char* W; size_t estride; bool gather;
    __device__ __forceinline__ bool next(int i, Unit& u) const {
        const int L = i * G + c, MT = __builtin_amdgcn_readfirstlane(tbl[16]); if (L >= MT * 4) return false;
        const int mt = L >> 2; int e = 0;
#pragma unroll
        for (int k = 1; k < 16; ++k) e = (__builtin_amdgcn_readfirstlane(tbl[k]) <= mt) ? k : e;
        const int rem = __builtin_amdgcn_readfirstlane(tbl[32 + e]) - (mt - __builtin_amdgcn_readfirstlane(tbl[e])) * BM;
        u.pm = mt; u.pn = L & 3; u.e = e; u.rows = rem < BM ? rem : BM; return true;
    }
    __device__ __forceinline__ int arow(const Unit& u, int r) const {
        if (!gather) return u.pm * BM + r;
        const int pos0 = (u.pm - tbl[u.e]) * BM; const int rr = r < u.rows ? r : u.rows - 1;
        return elist[(size_t)u.e * T + pos0 + rr];
    }
    __device__ __forceinline__ const char* bptr(const Unit& u) const { return W + (size_t)u.e * estride + (size_t)u.pn * BM * K * 2; }
};
}

namespace attn {
typedef short bf16x8 __attribute__((ext_vector_type(8)));
typedef float f32x16 __attribute__((ext_vector_type(16)));
constexpr float LOG2E = 1.4426950408889634f, C1 = 0.125f * LOG2E;
constexpr int KS_STRIDE = 144, VS_STRIDE = 520;
constexpr int L_KS = 0, L_VS = 36864, L_BL = L_VS + 33280, L_SCH = L_BL + 1024;
__device__ __forceinline__ int crow(int r, int hi) { return (r & 3) + 8 * (r >> 2) + 4 * hi; }
__device__ __forceinline__ unsigned cvtpk(float lo, float hi) { unsigned r; asm volatile("v_cvt_pk_bf16_f32 %0, %1, %2" : "=v"(r) : "v"(lo), "v"(hi)); return r; }

__device__ __forceinline__ void x1_select(Frame& F) {
    LAS float* km = (LAS float*)F.lds;
    LAS int* lc = (LAS int*)(F.lds + 8192);
    LAS int* gb = lc + 32;
    unsigned short* LIST = (unsigned short*)(F_ws + WS_LIST);
    for (int item = F.vcu; item < 16 * 31; item += F.G) {
        const int bh = item / 31, n = 1 + item % 31, b = bh >> 3, hd = bh & 7;
        for (int i = F.tid; i < n * 64; i += NT) km[i] = F_KMEAN[(size_t)bh * 2048 + i];
        if (F.tid < 32) lc[F.tid] = 0;
        __syncthreads();
        int s0 = -1, s1 = -1, s2 = -1, p0 = 0, p1 = 0, p2 = 0;
        if (F.tid < 256) {
            float q[64];
            { const GAS v4u* qp = (const GAS v4u*)(F_QB + ((size_t)(b * SEQ + n * 256 + F.tid)) * AW + hd * 64);
#pragma unroll
              for (int c = 0; c < 8; ++c) { const v4u w = qp[c];
                  q[8*c+0] = bf2f(w.x & 0xffff); q[8*c+1] = bf2f(w.x >> 16); q[8*c+2] = bf2f(w.y & 0xffff); q[8*c+3] = bf2f(w.y >> 16);
                  q[8*c+4] = bf2f(w.z & 0xffff); q[8*c+5] = bf2f(w.z >> 16); q[8*c+6] = bf2f(w.w & 0xffff); q[8*c+7] = bf2f(w.w >> 16); } }
            float g0 = -INFINITY, g1 = -INFINITY, g2 = -INFINITY;
            for (int j = 0; j < n; ++j) { float g = 0.f; const LAS f32x4* kp = (const LAS f32x4*)(km + j * 64);
#pragma unroll
                for (int c = 0; c < 16; ++c) { const f32x4 kv = kp[c]; g += q[4*c] * kv.x + q[4*c+1] * kv.y + q[4*c+2] * kv.z + q[4*c+3] * kv.w; }
                if (g > g0) { g2 = g1; s2 = s1; g1 = g0; s1 = s0; g0 = g; s0 = j; }
                else if (g > g1) { g2 = g1; s2 = s1; g1 = g; s1 = j; }
                else if (g > g2) { g2 = g; s2 = j; } }
            if (s0 >= 0) p0 = atomicAdd((int*)&lc[s0], 1);
            if (s1 >= 0) p1 = atomicAdd((int*)&lc[s1], 1);
            if (s2 >= 0) p2 = atomicAdd((int*)&lc[s2], 1);
        }
        __syncthreads();
        if (F.tid < n) gb[F.tid] = (int)__hip_atomic_fetch_add(F.ctl + CW_LCNT + bh * 32 + F.tid, (unsigned)lc[F.tid], RLX_AGENT);
        __syncthreads();
        if (F.tid < 256) { const unsigned qv = (unsigned)(n * 256 + F.tid);
            if (s0 >= 0) LIST[(size_t)(bh * 32 + s0) * 8192 + gb[s0] + p0] = (unsigned short)(qv);
            if (s1 >= 0) LIST[(size_t)(bh * 32 + s1) * 8192 + gb[s1] + p1] = (unsigned short)(qv | (1u << 13));
            if (s2 >= 0) LIST[(size_t)(bh * 32 + s2) * 8192 + gb[s2] + p2] = (unsigned short)(qv | (2u << 13)); }
        __syncthreads();
    }
}
__device__ __forceinline__ void stage_kv(Frame& F, int bh, int j) {
    const int b = bh >> 3, hd = bh & 7;
#pragma unroll
    for (int i = 0; i < 4; ++i) { const int idx = F.tid + NT * i, r = idx >> 3, c = idx & 7;
        const v4u v = *(const GAS v4u*)(F_KB + ((size_t)(b * SEQ + j * 256 + r)) * AW + hd * 64 + c * 8);
        *(LAS v4u*)(F.lds + L_KS + r * KS_STRIDE + c * 16) = v; }
#pragma unroll
    for (int i = 0; i < 4; ++i) { const int idx = F.tid + NT * i, d = idx >> 5, c = idx & 31;
        const v4u v = *(const GAS v4u*)(F_VT + ((size_t)(bh * 64 + d)) * SEQ + j * 256 + c * 8);
        LAS v2u* p = (LAS v2u*)(F.lds + L_VS + d * VS_STRIDE + c * 16); p[0] = (v2u){v.x, v.y}; p[1] = (v2u){v.z, v.w}; }
    if (F.tid < 129) ((LAS float*)(F.lds + L_BL))[F.tid] = F.tid == 0 ? -INFINITY : F_BIASN[hd * 128 + F.tid - 1] * LOG2E;
}
template <int MODE>
__device__ __forceinline__ void attn_core(LAS unsigned char* lds, const bf16x8 (&qf)[4], int qt, int kbase, int ntile, float& m_out, float& l_out, f32x16 (&o)[2], int lane) {
    const int r32 = lane & 31, hi = lane >> 5;
    f32x16 acc[8];
#pragma unroll
    for (int kt = 0; kt < 8; ++kt) {
        acc[kt] = (f32x16){};
#pragma unroll
        for (int s = 0; s < 4; ++s) { const bf16x8 a = *(const LAS bf16x8*)(lds + L_KS + (32 * kt + r32) * KS_STRIDE + 32 * s + 16 * hi);
            acc[kt] = __builtin_amdgcn_mfma_f32_32x32x16_bf16(a, qf[s], acc[kt], 0, 0, 0); }
        __builtin_amdgcn_sched_barrier(0); }
    const LAS float* BL = (const LAS float*)(lds + L_BL);
    int opq = 1; asm volatile("" : "+s"(opq));
    const bool near = (MODE == 1) ? (opq != 0) : (__any((qt >> 8) - 1 == (kbase >> 8)) != 0);
    const float b31 = BL[128];
    float mx = -INFINITY;
#pragma unroll
    for (int kt = 0; kt < 8; ++kt) {
        if (near) {
#pragma unroll
            for (int r = 0; r < 16; ++r) { const int dist = qt - (kbase + 32 * kt + crow(r, hi)); const int di = min(max(dist, -1), 127) + 1;
                const float t = acc[kt][r] * C1 + BL[di]; acc[kt][r] = t; mx = fmaxf(mx, t); }
        } else {
#pragma unroll
            for (int r = 0; r < 16; ++r) { const float t = acc[kt][r] * C1 + b31; acc[kt][r] = t; mx = fmaxf(mx, t); }
        }
        __builtin_amdgcn_sched_barrier(0); }
    mx = fmaxf(mx, __shfl_xor(mx, 32));
    float ls = 0.f;
#pragma unroll
    for (int kt = 0; kt < 8; ++kt) {
#pragma unroll
        for (int r = 0; r < 16; ++r) { const float p = __builtin_amdgcn_exp2f(acc[kt][r] - mx); acc[kt][r] = p; ls += p; } }
    ls += __shfl_xor(ls, 32);
    o[0] = (f32x16){}; o[1] = (f32x16){};
#pragma unroll
    for (int kt = 0; kt < 8; ++kt) {
#pragma unroll
        for (int s2 = 0; s2 < 2; ++s2) {
            v4u pw; pw.x = cvtpk(acc[kt][8*s2+0], acc[kt][8*s2+1]); pw.y = cvtpk(acc[kt][8*s2+2], acc[kt][8*s2+3]); pw.z = cvtpk(acc[kt][8*s2+4], acc[kt][8*s2+5]); pw.w = cvtpk(acc[kt][8*s2+6], acc[kt][8*s2+7]);
            const bf16x8 pf = __builtin_bit_cast(bf16x8, pw);
#pragma unroll
            for (int dt = 0; dt < 2; ++dt) { const LAS unsigned char* vp = lds + L_VS + (32 * dt + r32) * VS_STRIDE + 64 * kt + 32 * s2 + 8 * hi;
                const v2u lo = *(const LAS v2u*)vp, hv = *(const LAS v2u*)(vp + 16);
                const bf16x8 vf = __builtin_bit_cast(bf16x8, (v4u){lo.x, lo.y, hv.x, hv.y});
                o[dt] = __builtin_amdgcn_mfma_f32_32x32x16_bf16(vf, pf, o[dt], 0, 0, 0); } }
        __builtin_amdgcn_sched_barrier(0); }
    m_out = mx; l_out = ls;
}
__device__ __forceinline__ void load_q(Frame& F, bf16x8 (&qf)[4], int b, int hd, int qt, int hi) {
    const GAS v4u* qp = (const GAS v4u*)(F_QB + ((size_t)(b * SEQ + qt)) * AW + hd * 64 + 8 * hi);
#pragma unroll
    for (int s = 0; s < 4; ++s) qf[s] = __builtin_bit_cast(bf16x8, qp[2 * s]);
}
__device__ __forceinline__ void x2_partials(Frame& F) {
    LAS int* pre = (LAS int*)(F.lds + L_SCH);
    const unsigned short* LIST = (const unsigned short*)(F_ws + WS_LIST);
    bf16* POUT = (bf16*)F_out; float* ML = (float*)(F_ws + WS_ML);
    { const int c = (int)F.ctl[CW_LCNT + F.tid]; pre[1 + F.tid] = (((c + 31) >> 5) + 15) >> 4; }
    if (F.tid == 0) pre[0] = 0;
    __syncthreads();
    if (F.tid == 0) { int a = 0; for (int i = 1; i <= 512; ++i) { a += pre[i]; pre[i] = a; } }
    __syncthreads();
    const int NS = pre[512];
    const int r32 = F.lane & 31, hi = F.lane >> 5;
    for (int sidx = F.vcu; sidx < NS; sidx += F.G) {
        int lo = 0, hh = 512;
        while (hh - lo > 1) { const int mid = (lo + hh) >> 1; if (pre[mid] <= sidx) lo = mid; else hh = mid; }
        const int it = lo, bh = it >> 5, j = it & 31, b = bh >> 3, hd = bh & 7, sub = sidx - pre[it];
        const int Lj = (int)F.ctl[CW_LCNT + it], nch = (Lj + 31) >> 5;
        const int c0 = sub * 16, c1 = (c0 + 16 < nch) ? c0 + 16 : nch;
        stage_kv(F, bh, j);
        __syncthreads();
        for (int c = c0 + F.wave; c < c1; c += NWAVES) {
            const int idx = c * 32 + r32; const bool valid = idx < Lj;
            const unsigned e = LIST[(size_t)it * 8192 + (valid ? idx : Lj - 1)];
            const int qt = (int)(e & 8191u), slot = (int)(e >> 13);
            bf16x8 qf[4]; load_q(F, qf, b, hd, qt, hi);
            float m, l; f32x16 o[2];
            attn_core<0>(F.lds, qf, qt, j * 256, 8, m, l, o, F.lane);
            if (valid) { const size_t prow = ((size_t)slot * T + b * SEQ + qt) * 8 + hd;
                if (hi == 0) *(GAS f32x2*)(ML + prow * 2) = (f32x2){m, l};
#pragma unroll
                for (int dt = 0; dt < 2; ++dt)
#pragma unroll
                    for (int g = 0; g < 4; ++g) { v2u w; w.x = cvtpk(o[dt][4*g], o[dt][4*g+1]); w.y = cvtpk(o[dt][4*g+2], o[dt][4*g+3]);
                        *(GAS v2u*)(POUT + prow * 64 + 32 * dt + 8 * g + 4 * hi) = w; } }
        }
        __syncthreads();
    }
}
__device__ __forceinline__ void x3_own_merge(Frame& F) {
    const bf16* POUT = (const bf16*)F_out; const float* ML = (const float*)(F_ws + WS_ML);
    const int r32 = F.lane & 31, hi = F.lane >> 5;
    for (int item = F.vcu; item < 16 * 32; item += F.G) {
        const int bh = item >> 5, n = item & 31, b = bh >> 3, hd = bh & 7;
        stage_kv(F, bh, n);
        __syncthreads();
        int qt = n * 256 + 32 * F.wave + r32; asm volatile("" : "+v"(qt));
        bf16x8 qf[4]; load_q(F, qf, b, hd, qt, hi);
        float M, L; f32x16 o[2];
        attn_core<1>(F.lds, qf, qt, n * 256, F.wave + 1, M, L, o, F.lane);
        const int nsel = n < 3 ? n : 3;
        for (int s = 0; s < nsel; ++s) {
            const size_t prow = ((size_t)s * T + b * SEQ + qt) * 8 + hd;
            const f32x2 ml = *(const GAS f32x2*)(ML + prow * 2);
            const float Mn = fmaxf(M, ml.x), a = __builtin_amdgcn_exp2f(M - Mn), bs = __builtin_amdgcn_exp2f(ml.x - Mn);
            L = L * a + ml.y * bs; M = Mn;
#pragma unroll
            for (int dt = 0; dt < 2; ++dt)
#pragma unroll
                for (int g = 0; g < 4; ++g) { const v2u w = *(const GAS v2u*)(POUT + prow * 64 + 32 * dt + 8 * g + 4 * hi);
                    o[dt][4*g]   = o[dt][4*g]   * a + bf2f(w.x & 0xffff) * bs; o[dt][4*g+1] = o[dt][4*g+1] * a + bf2f(w.x >> 16) * bs;
                    o[dt][4*g+2] = o[dt][4*g+2] * a + bf2f(w.y & 0xffff) * bs; o[dt][4*g+3] = o[dt][4*g+3] * a + bf2f(w.y >> 16) * bs; }
        }
        const float inv = 1.f / L;
        bf16* arow = F_AR + ((size_t)(b * SEQ + qt)) * D + hd * 64;
#pragma unroll
        for (int dt = 0; dt < 2; ++dt)
#pragma unroll
            for (int g = 0; g < 4; ++g) { v2u w; w.x = cvtpk(o[dt][4*g] * inv, o[dt][4*g+1] * inv); w.y = cvtpk(o[dt][4*g+2] * inv, o[dt][4*g+3] * inv);
                *(GAS v2u*)(arow + 32 * dt + 8 * g + 4 * hi) = w; }
        __syncthreads();
    }
}
}

namespace hgrn {
typedef short bf16x8 __attribute__((ext_vector_type(8)));
typedef short s16x4 __attribute__((ext_vector_type(4)));
typedef float f32x16 __attribute__((ext_vector_type(16)));
constexpr int STR = 144;
constexpr int TILE = 64 * STR;
constexpr int L_TOT = 0, L_HF = 1024, L_HQ = L_HF + TILE, L_HI = L_HQ + TILE, L_ST = L_HI + TILE, L_AT = L_ST + TILE, L_OT = L_AT + TILE, HALF_BYTES = L_OT + TILE;
constexpr int L_KT = L_HF, L_QT = L_HQ, L_KP = L_HQ;
__device__ __forceinline__ int crow(int r, int hi) { return (r & 3) + 8 * (r >> 2) + 4 * hi; }
__device__ __forceinline__ s16x4 vtr(const LAS unsigned char* p) { return __builtin_bit_cast(s16x4, __builtin_amdgcn_ds_read_tr16_b64_v4i16((LAS s16x4*)p)); }
__device__ __forceinline__ bf16x8 btr32(const LAS unsigned char* tile, int st, int ct, int lane) {
    const int i = lane & 15, q = i >> 2, p = i & 3, hi = lane >> 5, cb = (lane >> 4) & 1;
    const LAS unsigned char* a = tile + (16 * st + 8 * hi + q) * STR + (32 * ct + 16 * cb + 4 * p) * 2;
    const s16x4 lo = vtr(a), hv = vtr(a + 4 * STR);
    return (bf16x8){lo[0], lo[1], lo[2], lo[3], hv[0], hv[1], hv[2], hv[3]};
}
__device__ __forceinline__ bf16x8 btr16(const LAS unsigned char* tile, int ks, int ct, int lane) {
    const int i = lane & 15, q = i >> 2, p = i & 3, kg = lane >> 4;
    const LAS unsigned char* a = tile + (32 * ks + 8 * kg + q) * STR + (16 * ct + 4 * p) * 2;
    const s16x4 lo = vtr(a), hv = vtr(a + 4 * STR);
    return (bf16x8){lo[0], lo[1], lo[2], lo[3], hv[0], hv[1], hv[2], hv[3]};
}
struct Pre { v4u hf[2], hi[2], hq[2]; f32x4 s[4]; };
template <bool H3>
__device__ __forceinline__ void pre_load(Frame& F, Pre& P, int ch, int ht) {
    const int bh = ch >> 7, c = ch & 127, b = bh >> 3, h = bh & 7, row0 = b * SEQ + c * 64;
#pragma unroll
    for (int i = 0; i < 2; ++i) { const int idx = ht + 256 * i, row = idx >> 3, cc = idx & 7; const size_t off = (size_t)(row0 + row) * AW + h * 64 + cc * 8;
        P.hf[i] = *(const GAS v4u*)(F_HF + off); P.hi[i] = *(const GAS v4u*)(F_HI + off); if (H3) P.hq[i] = *(const GAS v4u*)(F_HQ + off); }
    if (H3) { const float* KVS = (const float*)(F_ws + WS_XB);
#pragma unroll
        for (int i = 0; i < 4; ++i) { const int idx = ht + 256 * i; P.s[i] = *(const GAS f32x4*)(KVS + (size_t)ch * 4096 + idx * 4); } }
}
template <bool H3>
__device__ __forceinline__ void pre_store(LAS unsigned char* hb, const Pre& P, int ht) {
#pragma unroll
    for (int i = 0; i < 2; ++i) { const int idx = ht + 256 * i, row = idx >> 3, cc = idx & 7;
        *(LAS v4u*)(hb + L_HF + row * STR + cc * 16) = P.hf[i]; *(LAS v4u*)(hb + L_HI + row * STR + cc * 16) = P.hi[i];
        if (H3) *(LAS v4u*)(hb + L_HQ + row * STR + cc * 16) = P.hq[i]; }
}
__device__ __forceinline__ void gates(LAS unsigned char* hb, float lbk, int k, int sg, float (&f)[16], float (&p)[16]) {
    float run = 0.f;
#pragma unroll
    for (int i = 0; i < 16; ++i) { const float x = bf2f(*(const LAS bf16*)(hb + L_HF + (16 * sg + i) * STR + k * 2));
        f[i] = lbk + (1.f - lbk) * sigmoidf_(x); run += __logf(f[i]); p[i] = run; }
    ((LAS float*)(hb + L_TOT))[sg * 64 + k] = run;
}
__device__ __forceinline__ void h1_local(Frame& F) {
    float* KVS = (float*)(F_ws + WS_XB); float* DEC = (float*)(F_ws + WS_DECAY);
    const int half = F.tid >> 8, ht = F.tid & 255, hw = F.wave & 3, k = ht & 63, sg = hw, r32 = F.lane & 31, hi = F.lane >> 5;
    LAS unsigned char* hb = F.lds + half * HALF_BYTES;
    Pre P; int pair = F.vcu;
    if (pair < 1024) pre_load<false>(F, P, 2 * pair + half, ht);
    for (; pair < 1024; pair += F.G) {
        const int ch = 2 * pair + half, h = (ch >> 7) & 7;
        pre_store<false>(hb, P, ht);
        if (pair + F.G < 1024) pre_load<false>(F, P, 2 * (pair + F.G) + half, ht);
        const float lbk = F_LB[h * 64 + k];
        __syncthreads();
        float f[16], p[16]; gates(hb, lbk, k, sg, f, p);
        __syncthreads();
        const LAS float* tot = (const LAS float*)(hb + L_TOT);
        float off = 0.f, blast = 0.f;
#pragma unroll
        for (int s = 0; s < 4; ++s) { const float t = tot[s * 64 + k]; blast += t; off += (s < sg) ? t : 0.f; }
#pragma unroll
        for (int g = 0; g < 2; ++g) { unsigned w[4];
#pragma unroll
            for (int i = 0; i < 4; ++i) { const int a = 8 * g + 2 * i; w[i] = pk2((1.f - f[a]) * __expf(blast - (off + p[a])), (1.f - f[a + 1]) * __expf(blast - (off + p[a + 1]))); }
            *(LAS v4u*)(hb + L_KP + k * STR + sg * 32 + g * 16) = (v4u){w[0], w[1], w[2], w[3]}; }
        if (sg == 0) DEC[ch * 64 + k] = __expf(blast);
        __syncthreads();
        { const int kt = hw >> 1, vt = hw & 1; f32x16 acc = (f32x16){};
#pragma unroll
          for (int st = 0; st < 4; ++st) { const bf16x8 a = *(const LAS bf16x8*)(hb + L_KP + (32 * kt + r32) * STR + 32 * st + 16 * hi);
              acc = __builtin_amdgcn_mfma_f32_32x32x16_bf16(a, btr32(hb + L_HI, st, vt, F.lane), acc, 0, 0, 0); }
#pragma unroll
          for (int r = 0; r < 16; ++r) KVS[(size_t)ch * 4096 + (32 * kt + crow(r, hi)) * 64 + 32 * vt + r32] = acc[r]; }
        __syncthreads();
    }
}
__device__ __forceinline__ void h2_scan(Frame& F) {
    float* KVS = (float*)(F_ws + WS_XB); const float* DEC = (const float*)(F_ws + WS_DECAY);
    for (int e = blockIdx.x * NT + F.tid; e < 16 * 4096; e += F.G * NT) { const int bh = e >> 12, kv = e & 4095, k = kv >> 6;
        float st = 0.f;
        for (int c0 = 0; c0 < 128; c0 += 8) { float x[8], d[8];
#pragma unroll
            for (int u = 0; u < 8; ++u) { const int ch = bh * 128 + c0 + u; x[u] = KVS[(size_t)ch * 4096 + kv]; d[u] = DEC[ch * 64 + k]; }
#pragma unroll
            for (int u = 0; u < 8; ++u) { const int ch = bh * 128 + c0 + u; KVS[(size_t)ch * 4096 + kv] = st; st = d[u] * st + x[u]; } }
    }
}
__device__ __forceinline__ void h3_out(Frame& F) {
    const int half = F.tid >> 8, ht = F.tid & 255, hw = F.wave & 3, k = ht & 63, sg = hw, r32 = F.lane & 31, hi = F.lane >> 5, l15 = F.lane & 15, kg = F.lane >> 4;
    LAS unsigned char* hb = F.lds + half * HALF_BYTES;
    Pre P; int pair = F.vcu;
    if (pair < 1024) pre_load<true>(F, P, 2 * pair + half, ht);
    for (; pair < 1024; pair += F.G) {
        const int ch = 2 * pair + half, bh = ch >> 7, c = ch & 127, b = bh >> 3, h = bh & 7, row0 = b * SEQ + c * 64;
        pre_store<true>(hb, P, ht);
        f32x4 sv[4];
#pragma unroll
        for (int i = 0; i < 4; ++i) sv[i] = P.s[i];
        if (pair + F.G < 1024) pre_load<true>(F, P, 2 * (pair + F.G) + half, ht);
        const float lbk = F_LB[h * 64 + k];
        __syncthreads();
        float f[16], p[16]; gates(hb, lbk, k, sg, f, p);
        float qq[16];
#pragma unroll
        for (int i = 0; i < 16; ++i) { const float x = bf2f(*(const LAS bf16*)(hb + L_HQ + (16 * sg + i) * STR + k * 2)); qq[i] = x * sigmoidf_(x); }
        __syncthreads();
        const LAS float* tot = (const LAS float*)(hb + L_TOT);
        { float off = 0.f, bmid = 0.f;
#pragma unroll
          for (int s = 0; s < 4; ++s) { const float t = tot[s * 64 + k]; bmid += (s < 2) ? t : 0.f; off += (s < sg) ? t : 0.f; }
#pragma unroll
          for (int i = 0; i < 16; ++i) { const int t = 16 * sg + i; const float bt = off + p[i];
              *(LAS bf16*)(hb + L_QT + t * STR + k * 2) = (bf16)f2bf(qq[i] * __expf(bt - bmid));
              *(LAS bf16*)(hb + L_KT + t * STR + k * 2) = (bf16)f2bf((1.f - f[i]) * __expf(bmid - bt)); } }
#pragma unroll
        for (int i = 0; i < 4; ++i) { const int idx = ht + 256 * i, kk = idx >> 4, c4 = idx & 15; const float eb = __expf(tot[kk] + tot[64 + kk]);
            v2u w; w.x = pk2(sv[i].x * eb, sv[i].y * eb); w.y = pk2(sv[i].z * eb, sv[i].w * eb);
            *(LAS v2u*)(hb + L_ST + kk * STR + c4 * 8) = w; }
        __syncthreads();
        if (hw < 3) { const int tt = hw ? 1 : 0, st = (hw == 2) ? 1 : 0; f32x16 acc = (f32x16){};
#pragma unroll
            for (int ks = 0; ks < 4; ++ks) { const bf16x8 a = *(const LAS bf16x8*)(hb + L_QT + (32 * tt + r32) * STR + 32 * ks + 16 * hi);
                const bf16x8 bb = *(const LAS bf16x8*)(hb + L_KT + (32 * st + r32) * STR + 32 * ks + 16 * hi);
                acc = __builtin_amdgcn_mfma_f32_32x32x16_bf16(a, bb, acc, 0, 0, 0); }
#pragma unroll
            for (int r = 0; r < 16; ++r) { const int t = 32 * tt + crow(r, hi), s = 32 * st + r32;
                *(LAS bf16*)(hb + L_AT + t * STR + s * 2) = (bf16)f2bf(s <= t ? acc[r] : 0.f); }
        } else {
#pragma unroll
            for (int r = 0; r < 16; ++r) *(LAS bf16*)(hb + L_AT + crow(r, hi) * STR + (32 + r32) * 2) = (bf16)0;
        }
        const int t0 = 16 * hw; unsigned gv[4][4];
#pragma unroll
        for (int vt = 0; vt < 4; ++vt)
#pragma unroll
            for (int r = 0; r < 4; ++r) gv[vt][r] = F_HG[(size_t)(row0 + t0 + 4 * kg + r) * AW + h * 64 + 16 * vt + l15];
        __syncthreads();
        { f32x4 o[4];
#pragma unroll
          for (int vt = 0; vt < 4; ++vt) o[vt] = (f32x4){0.f, 0.f, 0.f, 0.f};
#pragma unroll
          for (int ks = 0; ks < 2; ++ks) { const bf16x8 aA = *(const LAS bf16x8*)(hb + L_AT + (t0 + l15) * STR + 64 * ks + 16 * kg);
              const bf16x8 aQ = *(const LAS bf16x8*)(hb + L_QT + (t0 + l15) * STR + 64 * ks + 16 * kg);
#pragma unroll
              for (int vt = 0; vt < 4; ++vt) {
                  o[vt] = __builtin_amdgcn_mfma_f32_16x16x32_bf16(aA, btr16(hb + L_HI, ks, vt, F.lane), o[vt], 0, 0, 0);
                  o[vt] = __builtin_amdgcn_mfma_f32_16x16x32_bf16(aQ, btr16(hb + L_ST, ks, vt, F.lane), o[vt], 0, 0, 0); } }
          float ss[4];
#pragma unroll
          for (int r = 0; r < 4; ++r) { float s = (o[0][r] * o[0][r] + o[1][r] * o[1][r]) + (o[2][r] * o[2][r] + o[3][r] * o[3][r]);
              s += __shfl_xor(s, 1); s += __shfl_xor(s, 2); s += __shfl_xor(s, 4); s += __shfl_xor(s, 8); ss[r] = rsqrtf(s * (1.f / 64.f) + RMS_EPS); }
#pragma unroll
          for (int vt = 0; vt < 4; ++vt) { const int v = 16 * vt + l15; const float nwv = F_nw[h * 64 + v];
#pragma unroll
              for (int r = 0; r < 4; ++r) *(LAS bf16*)(hb + L_OT + (t0 + 4 * kg + r) * STR + v * 2) = (bf16)f2bf(o[vt][r] * ss[r] * nwv * sigmoidf_(bf2f(gv[vt][r]))); } }
        __syncthreads();
#pragma unroll
        for (int i = 0; i < 2; ++i) { const int idx = ht + 256 * i, row = idx >> 3, cc = idx & 7;
            *(GAS v4u*)(F_AR + (size_t)(row0 + row) * D + AW + h * 64 + cc * 8) = *(const LAS v4u*)(hb + L_OT + row * STR + cc * 16); }
    }
}
}

template <class AM, class BMp, class Epi>
__device__ __forceinline__ void naive_gemm(Frame& F, const bf16* A, int lda, int M, const bf16* Bt, int ldb, int ntn, int K, AM amap, BMp bmap, Epi epi) {
    LAS float* As = (LAS float*)F.lds; LAS float* Bs = As + 64 * 33;
    const int tilesM = (M + 63) / 64, ty = F.tid >> 4, tx = F.tid & 15;
    for (int tile = blockIdx.x; tile < tilesM * ntn; tile += F.G) {
        const int tm = tile / ntn, tn = tile % ntn;
        float acc[2][4];
#pragma unroll
        for (int i = 0; i < 2; ++i)
#pragma unroll
            for (int j = 0; j < 4; ++j) acc[i][j] = 0.f;
        for (int k0 = 0; k0 < K; k0 += 32) {
#pragma unroll
            for (int i = 0; i < 4; ++i) { const int idx = F.tid + 512 * i, r = idx >> 5, kk = idx & 31, gr = tm * 64 + r;
                float v = 0.f; if (gr < M) { const int ar = amap(gr); v = bf2f(A[(size_t)ar * lda + k0 + kk]); }
                As[r * 33 + kk] = v;
                Bs[r * 33 + kk] = bf2f(Bt[(size_t)bmap(tn, r) * ldb + k0 + kk]); }
            __syncthreads();
#pragma unroll 8
            for (int kk = 0; kk < 32; ++kk) { const float a0 = As[ty * 33 + kk], a1 = As[(ty + 32) * 33 + kk];
#pragma unroll
                for (int j = 0; j < 4; ++j) { const float b = Bs[(tx + 16 * j) * 33 + kk]; acc[0][j] += a0 * b; acc[1][j] += a1 * b; } }
            __syncthreads();
        }
        epi(tm, tn, ty, tx, acc);
    }
}

__device__ __forceinline__ void naive_kmean(Frame& F) {
    const int gt = blockIdx.x * NT + F.tid, NGT = F.G * NT;
    for (int i = gt; i < 16 * 32 * 64; i += NGT) { const int d = i & 63, j = (i >> 6) & 31, bh = i >> 11, b = bh >> 3, h = bh & 7;
        const bf16* p = F_KB + ((size_t)(b * SEQ + j * 256)) * AW + h * 64 + d; float s = 0.f;
        for (int t = 0; t < 256; ++t) s += bf2f(p[(size_t)t * AW]);
        F_KMEAN[i] = s; }
}
__device__ __forceinline__ void naive_attn(Frame& F, bf16* ARdst) {
    const int NGT = F.G * NT;
    for (int gi = blockIdx.x * NT + F.tid; gi < 16 * SEQ; gi += NGT) {
        const int bh = gi >> 13, qi = gi & 8191, b = bh >> 3, h = bh & 7, n = qi >> 8;
        float q[64];
        { const GAS v4u* qp = (const GAS v4u*)(F_QB + ((size_t)(b * SEQ + qi)) * AW + h * 64);
#pragma unroll
          for (int c = 0; c < 8; ++c) { const v4u w = qp[c];
              q[8*c+0] = bf2f(w.x & 0xffff); q[8*c+1] = bf2f(w.x >> 16); q[8*c+2] = bf2f(w.y & 0xffff); q[8*c+3] = bf2f(w.y >> 16);
              q[8*c+4] = bf2f(w.z & 0xffff); q[8*c+5] = bf2f(w.z >> 16); q[8*c+6] = bf2f(w.w & 0xffff); q[8*c+7] = bf2f(w.w >> 16); } }
        int s0 = -1, s1 = -1, s2 = -1;
        const float* km = F_KMEAN + (size_t)bh * 32 * 64;
        for (int pass = 0; pass < 3; ++pass) {
            float best = -INFINITY; int bi = -1;
            for (int j = 0; j < n; ++j) { if (j == s0 || j == s1) continue; float g = 0.f;
#pragma unroll
                for (int d = 0; d < 64; ++d) g += q[d] * km[j * 64 + d];
                if (g > best) { best = g; bi = j; } }
            if (pass == 0) s0 = bi; else if (pass == 1) s1 = bi; else s2 = bi;
        }
        float m = -INFINITY, l = 0.f, o[64];
#pragma unroll
        for (int d = 0; d < 64; ++d) o[d] = 0.f;
        const float* bias = F_BIASN + h * 128;
        for (int bsel = 0; bsel < 4; ++bsel) {
            const int blk = bsel == 0 ? s0 : bsel == 1 ? s1 : bsel == 2 ? s2 : n;
            if (blk < 0) continue;
            const int ngrp = (bsel == 3) ? ((qi & 255) >> 3) + 1 : 32;
            for (int kg = 0; kg < ngrp; ++kg) {
                const int kp0 = blk * 256 + kg * 8; float s[8]; float gm = -INFINITY;
#pragma unroll
                for (int u = 0; u < 8; ++u) { const int kpos = kp0 + u;
                    const GAS v4u* kp = (const GAS v4u*)(F_KB + ((size_t)(b * SEQ + kpos)) * AW + h * 64); float dt = 0.f;
#pragma unroll
                    for (int c = 0; c < 8; ++c) { const v4u w = kp[c];
                        dt += q[8*c+0] * bf2f(w.x & 0xffff) + q[8*c+1] * bf2f(w.x >> 16) + q[8*c+2] * bf2f(w.y & 0xffff) + q[8*c+3] * bf2f(w.y >> 16)
                            + q[8*c+4] * bf2f(w.z & 0xffff) + q[8*c+5] * bf2f(w.z >> 16) + q[8*c+6] * bf2f(w.w & 0xffff) + q[8*c+7] * bf2f(w.w >> 16); }
                    const int dist = qi - kpos;
                    s[u] = (dist >= 0) ? dt * 0.125f + bias[dist > 127 ? 127 : dist] : -INFINITY;
                    gm = fmaxf(gm, s[u]); }
                const float mn = fmaxf(m, gm); const float alpha = __expf(m - mn); float p[8]; float ps = 0.f;
#pragma unroll
                for (int u = 0; u < 8; ++u) { p[u] = __expf(s[u] - mn); ps += p[u]; }
                l = l * alpha + ps; m = mn;
                const GAS v4u* vp = (const GAS v4u*)(F_VT + ((size_t)bh * 64) * SEQ + kp0);
#pragma unroll
                for (int d = 0; d < 64; ++d) { const v4u w = vp[(size_t)d * (SEQ / 8)];
                    o[d] = o[d] * alpha + p[0] * bf2f(w.x & 0xffff) + p[1] * bf2f(w.x >> 16) + p[2] * bf2f(w.y & 0xffff) + p[3] * bf2f(w.y >> 16)
                         + p[4] * bf2f(w.z & 0xffff) + p[5] * bf2f(w.z >> 16) + p[6] * bf2f(w.w & 0xffff) + p[7] * bf2f(w.w >> 16); }
            }
        }
        const float inv = 1.f / l;
        GAS unsigned* op = (GAS unsigned*)(ARdst + ((size_t)(b * SEQ + qi)) * D + h * 64);
#pragma unroll
        for (int d = 0; d < 64; d += 2) op[d >> 1] = pk2(o[d] * inv, o[d + 1] * inv);
    }
}
__device__ __forceinline__ void naive_hgrn(Frame& F) {
    if (F.wave != 0) return;
    for (int bh = blockIdx.x; bh < 16; bh += F.G) {
        const int b = bh >> 3, h = bh & 7, lane = F.lane;
        const float lb = F_LB[h * 64 + lane], nwv = F_nw[h * 64 + lane];
        float S[64];
#pragma unroll
        for (int k = 0; k < 64; ++k) S[k] = 0.f;
        LAS float* bc = (LAS float*)F.lds;
        for (int t0 = 0; t0 < SEQ; t0 += 8) {
#pragma unroll
            for (int u = 0; u < 8; ++u) { const size_t off = ((size_t)(b * SEQ + t0 + u)) * AW + h * 64 + lane;
                const float fl = bf2f(F_HF[off]), ql = bf2f(F_HQ[off]), vl = bf2f(F_HI[off]), gl = bf2f(F_HG[off]);
                const float f = lb + (1.f - lb) * sigmoidf_(fl);
                bc[u * 320 + lane] = f; bc[u * 320 + 64 + lane] = 1.f - f; bc[u * 320 + 128 + lane] = ql * sigmoidf_(ql);
                bc[u * 320 + 192 + lane] = vl; bc[u * 320 + 256 + lane] = sigmoidf_(gl); }
            LDS_WAIT(); asm volatile("" ::: "memory");
#pragma unroll 1
            for (int u = 0; u < 8; ++u) {
                const LAS float* pb = bc + u * 320;
                const float vv = pb[192 + lane], gs = pb[256 + lane];
                float o = 0.f;
#pragma unroll
                for (int k = 0; k < 64; k += 4) {
                    const f32x4 f4 = *(const LAS f32x4*)(pb + k), k4 = *(const LAS f32x4*)(pb + 64 + k), q4 = *(const LAS f32x4*)(pb + 128 + k);
                    S[k] = f4.x * S[k] + k4.x * vv; o += q4.x * S[k];
                    S[k + 1] = f4.y * S[k + 1] + k4.y * vv; o += q4.y * S[k + 1];
                    S[k + 2] = f4.z * S[k + 2] + k4.z * vv; o += q4.z * S[k + 2];
                    S[k + 3] = f4.w * S[k + 3] + k4.w * vv; o += q4.w * S[k + 3];
                    if ((k & 15) == 12) __builtin_amdgcn_sched_barrier(0); }
                const float ms = wave_sum(o * o) * (1.f / 64.f);
                const float r = o * rsqrtf(ms + RMS_EPS) * nwv * gs;
                F_AR[((size_t)(b * SEQ + t0 + u)) * D + AW + h * 64 + lane] = (bf16)f2bf(r);
            }
            LDS_WAIT(); asm volatile("" ::: "memory");
        }
    }
}

__device__ __forceinline__ void seg_bases(Frame& F, int (&base)[16], int (&cnt)[16]) {
    int acc = 0;
#pragma unroll
    for (int e = 0; e < 16; ++e) { cnt[e] = (int)F.ctl[CW_ECNT + e]; base[e] = acc; acc += (cnt[e] + 255) & ~255; }
}
__device__ __forceinline__ void p6_ln1_router(Frame& F) {
    LAS float* wrt = (LAS float*)F.lds;
    LAS float* lg = (LAS float*)(F.lds + 81920);
    LAS int* rinfo = (LAS int*)(F.lds + 81920 + 2560);
    LAS int* lcnt = rinfo + 256;
    LAS int* gbase = lcnt + 16;
    LAS int* lpos = gbase + 16;
    float* Y = F_out;
    for (int i = F.tid; i < 20 * 1024 / 4; i += NT) ((LAS f32x4*)wrt)[i] = ((const GAS f32x4*)F_WR)[i];
    const int lane = F.lane;
    for (int grp = F.vcu; grp < T / 64; grp += F.G) {
        if (F.tid < 16) lcnt[F.tid] = 0;
        __syncthreads();
        for (int half = 0; half < 2; ++half) {
            const int rl0 = F.wave * 8 + half * 4, m0 = grp * 64 + rl0;
            f32x4 v[4][4];
#pragma unroll
            for (int r = 0; r < 4; ++r)
#pragma unroll
                for (int j = 0; j < 4; ++j) v[r][j] = ((const GAS f32x4*)(Y + (size_t)(m0 + r) * D))[lane + 64 * j];
            float s[4], s2[4];
#pragma unroll
            for (int r = 0; r < 4; ++r) { s[r] = 0.f;
#pragma unroll
                for (int j = 0; j < 4; ++j) s[r] += (v[r][j].x + v[r][j].y) + (v[r][j].z + v[r][j].w); }
#pragma unroll
            for (int o = 1; o < 64; o <<= 1)
#pragma unroll
                for (int r = 0; r < 4; ++r) s[r] += __shfl_xor(s[r], o);
#pragma unroll
            for (int r = 0; r < 4; ++r) { const float mean = s[r] * (1.f / D); s2[r] = 0.f;
#pragma unroll
                for (int j = 0; j < 4; ++j) { v[r][j] = v[r][j] - mean; s2[r] += (v[r][j].x * v[r][j].x + v[r][j].y * v[r][j].y) + (v[r][j].z * v[r][j].z + v[r][j].w * v[r][j].w); } }
#pragma unroll
            for (int o = 1; o < 64; o <<= 1)
#pragma unroll
                for (int r = 0; r < 4; ++r) s2[r] += __shfl_xor(s2[r], o);
#pragma unroll
            for (int j = 0; j < 4; ++j) { const int c0 = 4 * lane + 256 * j;
                const f32x4 g = *(const GAS f32x4*)(F_ln1g + c0), bb = *(const GAS f32x4*)(F_ln1b + c0);
#pragma unroll
                for (int r = 0; r < 4; ++r) { const float rstd = rsqrtf(s2[r] * (1.f / D) + LN_EPS);
                    v[r][j] = v[r][j] * rstd * g + bb;
                    ((GAS f32x4*)(Y + (size_t)(m0 + r) * D))[lane + 64 * j] = v[r][j];
                    v2u o; o.x = pk2(v[r][j].x, v[r][j].y); o.y = pk2(v[r][j].z, v[r][j].w); ((GAS v2u*)(F_X1B + (size_t)(m0 + r) * D))[lane + 64 * j] = o; } }
            float acc[80];
#pragma unroll
            for (int i = 0; i < 80; ++i) acc[i] = 0.f;
#pragma unroll
            for (int k = 0; k < 20; ++k)
#pragma unroll
                for (int j = 0; j < 4; ++j) { const f32x4 w = ((const LAS f32x4*)(wrt + k * 1024))[lane + 64 * j];
#pragma unroll
                    for (int r = 0; r < 4; ++r) acc[r * 20 + k] += (v[r][j].x * w.x + v[r][j].y * w.y) + (v[r][j].z * w.z + v[r][j].w * w.w);
                    if (j == 3 && (k & 1)) __builtin_amdgcn_sched_barrier(0); }
#define HSTEP(H, MASK) { const bool up = (lane & (MASK)) != 0; _Pragma("unroll") for (int i = 0; i < (H); ++i) { \
                const float snd = up ? acc[i] : acc[(H) + i]; const float rcv = __shfl_xor(snd, (MASK)); acc[i] = (up ? acc[(H) + i] : acc[i]) + rcv; } }
            HSTEP(40, 32) HSTEP(20, 16) HSTEP(10, 8) HSTEP(5, 4)
#undef HSTEP
#pragma unroll
            for (int i = 0; i < 5; ++i) { acc[i] += __shfl_xor(acc[i], 2); acc[i] += __shfl_xor(acc[i], 1); }
            if ((lane & 3) == 0) { const int g0 = 40 * ((lane >> 5) & 1) + 20 * ((lane >> 4) & 1) + 10 * ((lane >> 3) & 1) + 5 * ((lane >> 2) & 1);
#pragma unroll
                for (int i = 0; i < 5; ++i) lg[F.wave * 80 + g0 + i] = acc[i]; }
            LDS_WAIT(); asm volatile("" ::: "memory");
            if (lane < 4) { const int rl = rl0 + lane; const LAS float* lp = lg + F.wave * 80 + lane * 20;
                float gl[4]; int gi = 0; float gmx = -INFINITY;
#pragma unroll
                for (int g = 0; g < 4; ++g) { gl[g] = lp[g] + F_b_grp[g]; if (gl[g] > gmx) { gmx = gl[g]; gi = g; } }
                float gs = 0.f;
#pragma unroll
                for (int g = 0; g < 4; ++g) gs += __expf(gl[g] - gmx);
                const float gw = 1.f / gs;
                float el[4];
#pragma unroll
                for (int e = 0; e < 4; ++e) el[e] = lp[4 + 4 * gi + e] + F_b_exp[gi * 4 + e];
                int e0 = 0; float mm0 = -INFINITY;
#pragma unroll
                for (int e = 0; e < 4; ++e) if (el[e] > mm0) { mm0 = el[e]; e0 = e; }
                int e1 = 0; float mm1 = -INFINITY;
#pragma unroll
                for (int e = 0; e < 4; ++e) if (e != e0 && el[e] > mm1) { mm1 = el[e]; e1 = e; }
                const float p1 = __expf(mm1 - mm0), w0 = gw / (1.f + p1), w1 = gw * p1 / (1.f + p1);
                rinfo[rl * 4 + 0] = gi * 4 + e0; rinfo[rl * 4 + 1] = gi * 4 + e1;
                rinfo[rl * 4 + 2] = __builtin_bit_cast(int, w0); rinfo[rl * 4 + 3] = __builtin_bit_cast(int, w1); }
            LDS_WAIT(); asm volatile("" ::: "memory");
        }
        __syncthreads();
        if (F.tid < 128) { const int rl = F.tid >> 1, s = F.tid & 1; lpos[F.tid] = atomicAdd((int*)&lcnt[rinfo[rl * 4 + s]], 1); }
        __syncthreads();
        { int te = F.tid; asm volatile("" : "+v"(te));
          if (te < 16) gbase[te] = (int)__hip_atomic_fetch_add(F.ctl + CW_ECNT + te, (unsigned)lcnt[te], RLX_AGENT); }
        __syncthreads();
        if (F.tid < 128) { const int rl = F.tid >> 1, s = F.tid & 1, e = rinfo[rl * 4 + s], pos = gbase[e] + lpos[F.tid], m = grp * 64 + rl;
            const float w = __builtin_bit_cast(float, rinfo[rl * 4 + 2 + s]);
            F_ELIST[(size_t)e * T + pos] = m; F_EW[(size_t)e * T + pos] = w;
            F_TOKE[m * 2 + s] = e; F_TOKP[m * 2 + s] = pos; F_TOKW[m * 2 + s] = w; }
        __syncthreads();
    }
}
__device__ __forceinline__ void p9_final(Frame& F) {
    int base[16], cnt[16]; seg_bases(F, base, cnt);
    const int gw = F.vcu * NWAVES + F.wave, NGW = F.G * NWAVES, lane = F.lane;
    for (int m0 = gw * 4; m0 < T; m0 += NGW * 4) {
        f32x4 v[4][4];
#pragma unroll
        for (int r = 0; r < 4; ++r) { const int m = m0 + r;
            int r0 = 0, r1 = 0; { const int e0 = F_TOKE[m * 2], e1 = F_TOKE[m * 2 + 1], p0 = F_TOKP[m * 2], p1 = F_TOKP[m * 2 + 1];
#pragma unroll
                for (int e = 0; e < 16; ++e) { r0 = (e == e0) ? base[e] + p0 : r0; r1 = (e == e1) ? base[e] + p1 : r1; } }
            const GAS f32x4* xr = (const GAS f32x4*)(F_out + (size_t)m * D) + lane;
            const GAS v2u* y0 = (const GAS v2u*)(F_YE + (size_t)r0 * D) + lane; const GAS v2u* y1 = (const GAS v2u*)(F_YE + (size_t)r1 * D) + lane;
#pragma unroll
            for (int j = 0; j < 4; ++j) { const f32x4 xv = xr[64 * j]; const v2u a = y0[64 * j], c = y1[64 * j];
                v[r][j].x = ALPHA * xv.x + bf2f(a.x & 0xffff) + bf2f(c.x & 0xffff); v[r][j].y = ALPHA * xv.y + bf2f(a.x >> 16) + bf2f(c.x >> 16);
                v[r][j].z = ALPHA * xv.z + bf2f(a.y & 0xffff) + bf2f(c.y & 0xffff); v[r][j].w = ALPHA * xv.w + bf2f(a.y >> 16) + bf2f(c.y >> 16); } }
        float s[4], s2[4];
#pragma unroll
        for (int r = 0; r < 4; ++r) { s[r] = 0.f;
#pragma unroll
            for (int j = 0; j < 4; ++j) s[r] += (v[r][j].x + v[r][j].y) + (v[r][j].z + v[r][j].w); }
#pragma unroll
        for (int o = 1; o < 64; o <<= 1)
#pragma unroll
            for (int r = 0; r < 4; ++r) s[r] += __shfl_xor(s[r], o);
#pragma unroll
        for (int r = 0; r < 4; ++r) { const float mean = s[r] * (1.f / D); s2[r] = 0.f;
#pragma unroll
            for (int j = 0; j < 4; ++j) { v[r][j] = v[r][j] - mean; s2[r] += (v[r][j].x * v[r][j].x + v[r][j].y * v[r][j].y) + (v[r][j].z * v[r][j].z + v[r][j].w * v[r][j].w); } }
#pragma unroll
        for (int o = 1; o < 64; o <<= 1)
#pragma unroll
            for (int r = 0; r < 4; ++r) s2[r] += __shfl_xor(s2[r], o);
#pragma unroll
        for (int j = 0; j < 4; ++j) { const int c0 = 4 * lane + 256 * j;
            const f32x4 g = *(const GAS f32x4*)(F_ln2g + c0), bb = *(const GAS f32x4*)(F_ln2b + c0);
#pragma unroll
            for (int r = 0; r < 4; ++r) { const int m = m0 + r; const float rstd = rsqrtf(s2[r] * (1.f / D) + LN_EPS);
                GAS f32x4* xr = (GAS f32x4*)(F_out + (size_t)m * D) + lane;
#if defined(PROBE_A) || defined(PROBE_B)
                f32x4 res = v[r][j] * rstd * g + bb;
#ifdef PROBE_A
                if (m == 0 && lane == 0 && j == 0) { const unsigned long long t1 = ((unsigned long long)F.ctl[9101 + 2 * (PROBE_A + 1)] << 32) | F.ctl[9100 + 2 * (PROBE_A + 1)], t0 = ((unsigned long long)F.ctl[9101 + 2 * PROBE_A] << 32) | F.ctl[9100 + 2 * PROBE_A];
                    res.x += (float)(t1 - t0) * 0.001f; }
#endif
#ifdef PROBE_B
                if (m < 1024 && lane == 0 && j == 0) { const unsigned long long t1 = ((unsigned long long)F.ctl[9101 + 2 * (PROBE_B + 1)] << 32) | F.ctl[9100 + 2 * (PROBE_B + 1)], t0 = ((unsigned long long)F.ctl[9101 + 2 * PROBE_B] << 32) | F.ctl[9100 + 2 * PROBE_B];
                    res.y += (float)(t1 - t0) * 0.0001f; }
#endif
                xr[64 * j] = res;
#else
                xr[64 * j] = v[r][j] * rstd * g + bb;
#endif
            } }
    }
}

constexpr int MOETBL_OFF = LDSCTL_OFF + 1024;
__device__ __forceinline__ const LAS int* moe_tables(Frame& F) {
    LAS int* tbl = (LAS int*)(F.lds + MOETBL_OFF);
    if (F.tid == 0) { int acc = 0;
        for (int e = 0; e < 16; ++e) { const int c = (int)F.ctl[CW_ECNT + e]; tbl[e] = acc; tbl[32 + e] = c; acc += (c + 255) >> 8; }
        tbl[16] = acc; }
    __syncthreads();
    return tbl;
}
constexpr int NPHASE = 10;
__global__ void __launch_bounds__(NT, 2) fwd(Args args) {
    extern __shared__ __attribute__((aligned(16))) unsigned char lds[];
    Frame F;
    F.lds = (LAS unsigned char*)lds;
    F.tid = threadIdx.x; F.lane = F.tid & 63; F.wave = __builtin_amdgcn_readfirstlane(F.tid >> 6);
    F.G = gridDim.x; { const int bx = blockIdx.x; F.vcu = (F.G % 8 == 0) ? (bx % 8) * (F.G / 8) + bx / 8 : bx; }
    F.a = &args;
    F.ctl = (gu32*)(args.ws + WS_CTL);
    for (int u = F.tid; u < (LDS_BYTES - LDSCTL_OFF) / 4; u += NT) ((LAS unsigned*)(F.lds + LDSCTL_OFF))[u] = 0u;
    __syncthreads();
    XcdBarrier bar = xcd_barrier_post((unsigned*)(F.ctl + CW_BAR), (volatile LAS unsigned*)(F.lds + MISC_OFF) + 8);
    const int lo = args.ph_lo, hi = args.ph_hi;
#define IN(k) (lo <= (k) && (k) < hi)
#if defined(PROBE_A) || defined(PROBE_B)
#define STAMP(k) do { __syncthreads(); if (blockIdx.x == 0 && F.tid == 0) { const unsigned long long t_ = __builtin_amdgcn_s_memrealtime(); F.ctl[9100 + 2 * ((k) + 1)] = (unsigned)t_; F.ctl[9101 + 2 * ((k) + 1)] = (unsigned)(t_ >> 32); } } while (0)
#else
#define STAMP(k) do { } while (0)
#endif
#define SEAM(k) do { if (IN(k) && IN((k) + 1)) xcd_barrier(bar); STAMP(k); } while (0)

    STAMP(-1);
    if (IN(0)) { p0_prologue(F); } SEAM(0);
#if OPT_GEMM
    if (IN(1)) {
        pg8::StaticOrder S; S.init(T, INW, D, F.G, (int)blockIdx.x, F_WIN_T); pg8::EpiInProj E{F_ws, F_KMEAN};
        pg8::gemm_phase<pg8::EpiInProj, pg8::StaticOrder, true>(F.lds, F_XB, D, S, E);
    } SEAM(1);
#else
    if (IN(1)) {
        naive_gemm(F, F_XB, D, T, F_WIN_T, D, INW / 64, D, [](int r) { return r; }, [](int tn, int c) { return tn * 64 + c; },
            [&](int tm, int tn, int ty, int tx, float (&acc)[2][4]) {
#pragma unroll
                for (int i = 0; i < 2; ++i)
#pragma unroll
                    for (int j = 0; j < 4; ++j) { const int row = tm * 64 + ty + 32 * i, col = tn * 64 + tx + 16 * j, grp = col >> 9, cc = col & 511;
                        const bf16 v = (bf16)f2bf(acc[i][j]);
                        if (grp == 2) { const int b = row >> 13, t = row & 8191; F_VT[((size_t)(b * 8 + (cc >> 6)) * 64 + (cc & 63)) * SEQ + t] = v; }
                        else ((bf16*)(F_ws + WS_PROJ + (size_t)grp * PROJ_SLOT))[(size_t)row * AW + cc] = v; }
            });
    } SEAM(1);
#endif
    if (IN(2)) {
#if !OPT_GEMM
        naive_kmean(F);
#if OPT_ATTN
        xcd_barrier(bar);
#endif
#endif
#if OPT_ATTN
        attn::x1_select(F); STAMP(20);
#endif
#if OPT_HGRN
        hgrn::h1_local(F);
#endif
    } SEAM(2);
#if OPT_ATTN
#if OPT_HGRN
    if (IN(3)) { attn::x2_partials(F); STAMP(21); hgrn::h2_scan(F); } SEAM(3);
#else
    if (IN(3)) { attn::x2_partials(F); naive_hgrn(F); } SEAM(3);
#endif
    if (IN(4)) { attn::x3_own_merge(F); STAMP(22);
#if OPT_HGRN
        hgrn::h3_out(F);
#endif
#ifdef DBG_ATTN
        naive_attn(F, F_XB);
        xcd_barrier(bar);
        { float num = 0.f, den = 0.f;
          for (size_t i = (size_t)blockIdx.x * NT + F.tid; i < (size_t)T * 512; i += (size_t)F.G * NT) { const size_t o = (i >> 9) * D + (i & 511);
              const float a = bf2f(F_AR[o]), r = bf2f(F_XB[o]); num += (a - r) * (a - r); den += r * r; }
          num = wave_sum(num); den = wave_sum(den);
          if (F.lane == 0) { atomicAdd((float*)(F.ctl + 9000), num); atomicAdd((float*)(F.ctl + 9001), den); } }
#endif
    } SEAM(4);
#else
    if (IN(3)) { naive_attn(F, F_AR); naive_hgrn(F); } SEAM(3);
    if (IN(4)) { } SEAM(4);
#endif
#if OPT_GEMM
    if (IN(5)) {
        pg8::StaticOrder S; S.init(T, D, D, F.G, (int)blockIdx.x, F_WO_T); pg8::EpiOutProj E{F_x, F_out};
        pg8::gemm_phase<pg8::EpiOutProj, pg8::StaticOrder, true>(F.lds, F_AR, D, S, E);
    } SEAM(5);
#else
    if (IN(5)) {
        naive_gemm(F, F_AR, D, T, F_WO_T, D, D / 64, D, [](int r) { return r; }, [](int tn, int c) { return tn * 64 + c; },
            [&](int tm, int tn, int ty, int tx, float (&acc)[2][4]) {
#pragma unroll
                for (int i = 0; i < 2; ++i)
#pragma unroll
                    for (int j = 0; j < 4; ++j) { const size_t o = (size_t)(tm * 64 + ty + 32 * i) * D + tn * 64 + tx + 16 * j; F_out[o] = ALPHA * F_x[o] + acc[i][j]; }
            });
    } SEAM(5);
#endif
    if (IN(6)) { p6_ln1_router(F); } SEAM(6);
#if OPT_GEMM
    if (IN(7)) {
        const LAS int* tbl = moe_tables(F);
        pg8::MoeOrder S{tbl, F.G, F.vcu, D, F_ELIST, (const char*)F_WGU_T, (size_t)1024 * 1024 * 2, true}; pg8::EpiMoe1 E{F_HB};
        pg8::gemm_phase<pg8::EpiMoe1, pg8::MoeOrder, true>(F.lds, F_X1B, D, S, E);
    } SEAM(7);
    if (IN(8)) {
        const LAS int* tbl = moe_tables(F);
        pg8::MoeOrder S{tbl, F.G, F.vcu, DE, nullptr, (const char*)F_WD_T, (size_t)1024 * 512 * 2, false}; pg8::EpiMoe2 E{F_YE, F_EW, tbl};
        pg8::gemm_phase<pg8::EpiMoe2, pg8::MoeOrder, true>(F.lds, F_HB, DE, S, E);
    } SEAM(8);
#else
    if (IN(7)) {
        int base[16], cnt[16]; seg_bases(F, base, cnt);
        for (int e = 0; e < 16; ++e) {
            const int* el = F_ELIST + (size_t)e * T; const int be = base[e], ce = cnt[e];
            naive_gemm(F, F_X1B, D, ce, F_WGU_T + (size_t)e * 1024 * 1024, D, DE / 32, D, [&](int r) { return el[r]; },
                [](int tn, int c) { const int j = tn * 32 + (c & 31); return 256 * (j >> 7) + (j & 127) + ((c >> 5) ? 128 : 0); },
                [&](int tm, int tn, int ty, int tx, float (&acc)[2][4]) {
#pragma unroll
                    for (int i = 0; i < 2; ++i)
#pragma unroll
                        for (int j = 0; j < 2; ++j) { const int row = tm * 64 + ty + 32 * i; if (row < ce) { const float g = acc[i][j], u = acc[i][j + 2];
                            F_HB[(size_t)(be + row) * DE + tn * 32 + tx + 16 * j] = (bf16)f2bf(g * sigmoidf_(g) * u); } }
                });
        }
    } SEAM(7);
    if (IN(8)) {
        int base[16], cnt[16]; seg_bases(F, base, cnt);
        for (int e = 0; e < 16; ++e) {
            const int be = base[e], ce = cnt[e]; const float* ew = F_EW + (size_t)e * T;
            naive_gemm(F, F_HB + (size_t)be * DE, DE, ce, F_WD_T + (size_t)e * 1024 * 512, DE, D / 64, DE, [](int r) { return r; }, [](int tn, int c) { return tn * 64 + c; },
                [&](int tm, int tn, int ty, int tx, float (&acc)[2][4]) {
#pragma unroll
                    for (int i = 0; i < 2; ++i)
#pragma unroll
                        for (int j = 0; j < 4; ++j) { const int row = tm * 64 + ty + 32 * i; if (row < ce)
                            F_YE[(size_t)(be + row) * D + tn * 64 + tx + 16 * j] = (bf16)f2bf(acc[i][j] * ew[row]); }
                });
        }
    } SEAM(8);
#endif
    if (IN(9)) { p9_final(F); }
#undef IN
#undef SEAM
}

extern "C" void kernel_launch(void* const* d_in, const int* in_sizes, int n_in, void* d_out, int out_size, void* d_ws, size_t ws_size, hipStream_t stream) {
    static int grid = 0;
    if (grid == 0) {
        if (n_in != 17 || in_sizes[0] != T * D || out_size != T * D || ws_size < WS_END) { fprintf(stderr, "kernel_launch: unexpected shapes (n_in %d, in0 %d, out %d, ws %zu)\n", n_in, n_in > 0 ? in_sizes[0] : -1, out_size, ws_size); grid = -1; return; }
        int dev = 0, cus = 0;
        if (hipGetDevice(&dev) != hipSuccess || hipDeviceGetAttribute(&cus, hipDeviceAttributeMultiprocessorCount, dev) != hipSuccess) { grid = -1; return; }
        if (hipFuncSetAttribute((const void*)fwd, hipFuncAttributeMaxDynamicSharedMemorySize, LDS_BYTES) != hipSuccess) { fprintf(stderr, "kernel_launch: hipFuncSetAttribute failed\n"); grid = -1; return; }
        (void)hipGetLastError();
        grid = cus;
    }
    if (grid < 0) return;
    if (hipMemsetAsync((char*)d_ws + WS_CTL, 0, CTL_ZERO_BYTES, stream) != hipSuccess) return;
    Args a{};
    for (int i = 0; i < 17; ++i) a.in[i] = (const float*)d_in[i];
    a.out = (float*)d_out; a.ws = (unsigned char*)d_ws; a.ph_lo = 0; a.ph_hi = NPHASE;
    hipLaunchKernelGGL(fwd, dim3(grid), dim3(NT), LDS_BYTES, stream, a);
}
```
